# Optimizing an MI355X kernel written in HIP

```python
import math
import jax, jax.numpy as jnp
from jax import lax
import numpy as np

D_MODEL = 1024
BATCH = 16
SEQ = 2048
DEPTH = 1
DEC_BATCH = 2
DEC_SEQ = 16384
PAST_LEN = 128

N_ATTN_HEADS = 4
QK_DIM = 64
V_DIM = 2 * QK_DIM
ATTN_WIDTH = N_ATTN_HEADS * V_DIM
QK_WIDTH = N_ATTN_HEADS * 2 * QK_DIM
N_FOURIER_GROUPS = 4
FOURIER_GROUP_DIM = 128
FOURIER_WIDTH = N_FOURIER_GROUPS * FOURIER_GROUP_DIM
MIX_WIDTH = ATTN_WIDTH + FOURIER_WIDTH
IN_WIDTH = 2 * QK_WIDTH + ATTN_WIDTH + FOURIER_WIDTH
D_FF = -(-8 * D_MODEL // (3 * 256)) * 256
ROPE_THETA = 10000.0
Q_BLOCK = 128
LN_EPS = 1e-5
ALPHA = (2 * DEPTH) ** 0.25
BETA = (8 * DEPTH) ** -0.25
N_MOD = 6

kernel_name = 'hymba_fnet_diffattn_deepnorm_encoder'


def _layer_norm(x):
    xf = x.astype(jnp.float32)
    mu = xf.mean(-1, keepdims=True)
    var = jnp.square(xf - mu).mean(-1, keepdims=True)
    return ((xf - mu) * lax.rsqrt(var + LN_EPS)).astype(x.dtype)


def _rms_norm(x):
    xf = x.astype(jnp.float32)
    return (xf * lax.rsqrt(jnp.mean(xf * xf, -1, keepdims=True) + LN_EPS)).astype(x.dtype)


def _rope_tables(seq):
    inv = ROPE_THETA ** (-jnp.arange(0, QK_DIM, 2, dtype=jnp.float32) / QK_DIM)
    ang = jnp.arange(seq, dtype=jnp.float32)[:, None] * inv[None, :]
    return jnp.cos(ang), jnp.sin(ang)


def _apply_rope(x, cos, sin):
    c = cos[None, :, None, None, :]
    s = sin[None, :, None, None, :]
    x1, x2 = jnp.split(x.astype(jnp.float32), 2, axis=-1)
    return jnp.concatenate([x1 * c - x2 * s, x2 * c + x1 * s], axis=-1).astype(x.dtype)


def _diff_attention(q, k, v, lam):
    b, s = q.shape[0], q.shape[1]
    nb = s // Q_BLOCK
    scale = QK_DIM ** -0.5
    qb = q.reshape(b, nb, Q_BLOCK, N_ATTN_HEADS, 2, QK_DIM).transpose(1, 0, 2, 3, 4, 5)

    def block(qi):
        sc = jnp.einsum('bqhcd,bkhcd->bhcqk', qi, k, preferred_element_type=jnp.float32) * scale
        p = jax.nn.softmax(sc, axis=-1)
        w = p[:, :, 0] - lam * p[:, :, 1]
        return jnp.einsum('bhqk,bkhd->bqhd', w.astype(v.dtype), v)

    o = lax.map(block, qb)
    return o.transpose(1, 0, 2, 3, 4).reshape(b, s, N_ATTN_HEADS, V_DIM)


def _fourier_mix(u, w_f):
    b, s, _ = u.shape
    ug = u.reshape(b, s, N_FOURIER_GROUPS, FOURIER_GROUP_DIM).astype(jnp.float32)
    f = jnp.fft.fft2(ug, axes=(1, 3), norm='ortho').real.astype(u.dtype)
    return jnp.einsum('bsgc,gcd->bsgd', f, w_f).reshape(b, s, FOURIER_WIDTH)


def _layer(x, c, l, w_ada, b_ada, w_in, lambda_q1, lambda_k1, lambda_q2, lambda_k2, subln_g,
           w_fourier, w_out, ln1_g, ln1_b, w_gate, w_up, w_down, ln2_g, ln2_b):
    b, s, _ = x.shape
    lambda_init = 0.8 - 0.6 * math.exp(-0.3 * l)
    mod = jnp.einsum('bd,de->be', jax.nn.silu(c), w_ada[l]) + b_ada[l]
    sh1, sc1, g1, sh2, sc2, g2 = jnp.split(mod[:, None, :], N_MOD, axis=-1)

    h = _layer_norm(x) * (1 + sc1) + sh1
    proj = jnp.einsum('bsd,de->bse', h, w_in[l])
    q, k, v, u = jnp.split(proj, [QK_WIDTH, 2 * QK_WIDTH, 2 * QK_WIDTH + ATTN_WIDTH], axis=-1)
    cos, sin = _rope_tables(s)
    q = _apply_rope(q.reshape(b, s, N_ATTN_HEADS, 2, QK_DIM), cos, sin)
    k = _apply_rope(k.reshape(b, s, N_ATTN_HEADS, 2, QK_DIM), cos, sin)
    v = v.reshape(b, s, N_ATTN_HEADS, V_DIM)
    lam = (jnp.exp(jnp.sum(lambda_q1[l].astype(jnp.float32) * lambda_k1[l].astype(jnp.float32)))
           - jnp.exp(jnp.sum(lambda_q2[l].astype(jnp.float32) * lambda_k2[l].astype(jnp.float32)))
           + lambda_init)
    o = _diff_attention(q, k, v, lam)
    o = _rms_norm(o) * subln_g[l] * (1 - lambda_init)
    f = _fourier_mix(u, w_fourier[l])
    mixed = jnp.concatenate([o.reshape(b, s, ATTN_WIDTH), f], axis=-1)
    mix_out = jnp.einsum('bse,ed->bsd', mixed, w_out[l])
    x = _layer_norm(ALPHA * x + (1 + g1) * mix_out) * ln1_g[l] + ln1_b[l]

    h = _layer_norm(x) * (1 + sc2) + sh2
    a = jax.nn.silu(jnp.einsum('bsd,df->bsf', h, w_gate[l])) * jnp.einsum('bsd,df->bsf', h, w_up[l])
    ffn = jnp.einsum('bsf,fd->bsd', a, w_down[l])
    x = _layer_norm(ALPHA * x + (1 + g2) * ffn) * ln2_g[l] + ln2_b[l]
    return x


def setup_inputs(seed: int = 0) -> dict:
    key = jax.random.key(seed)
    ks = jax.random.split(key, 24)
    nrm = lambda k, shape, s: jax.random.normal(k, shape, jnp.float32) * s
    w_in = nrm(ks[4], (DEPTH, D_MODEL, IN_WIDTH), D_MODEL ** -0.5)
    v_scale = jnp.concatenate([jnp.ones((2 * QK_WIDTH,), jnp.float32),
                               jnp.full((ATTN_WIDTH,), BETA, jnp.float32),
                               jnp.ones((FOURIER_WIDTH,), jnp.float32)])
    w_in = w_in * v_scale
    return {
        'x_prompt': nrm(ks[0], (BATCH, SEQ, D_MODEL), 1.0),
        'x_sample': nrm(ks[1], (DEC_BATCH, DEC_SEQ, D_MODEL), 1.0),
        'c_prompt': nrm(ks[2], (BATCH, D_MODEL), 1.0),
        'c_sample': nrm(ks[3], (DEC_BATCH, D_MODEL), 1.0),
        'w_ada': nrm(ks[5], (DEPTH, D_MODEL, N_MOD * D_MODEL), 0.1 * D_MODEL ** -0.5),
        'b_ada': nrm(ks[6], (DEPTH, N_MOD * D_MODEL), 0.01),
        'w_in': w_in,
        'lambda_q1': nrm(ks[7], (DEPTH, QK_DIM), 0.1),
        'lambda_k1': nrm(ks[8], (DEPTH, QK_DIM), 0.1),
        'lambda_q2': nrm(ks[9], (DEPTH, QK_DIM), 0.1),
        'lambda_k2': nrm(ks[10], (DEPTH, QK_DIM), 0.1),
        'subln_g': 1.0 + nrm(ks[11], (DEPTH, V_DIM), 0.02),
        'w_fourier': nrm(ks[12], (DEPTH, N_FOURIER_GROUPS, FOURIER_GROUP_DIM, FOURIER_GROUP_DIM), FOURIER_GROUP_DIM ** -0.5),
        'w_out': nrm(ks[13], (DEPTH, MIX_WIDTH, D_MODEL), BETA * MIX_WIDTH ** -0.5),
        'ln1_g': 1.0 + nrm(ks[14], (DEPTH, D_MODEL), 0.02),
        'ln1_b': nrm(ks[15], (DEPTH, D_MODEL), 0.02),
        'w_gate': nrm(ks[16], (DEPTH, D_MODEL, D_FF), BETA * D_MODEL ** -0.5),
        'w_up': nrm(ks[17], (DEPTH, D_MODEL, D_FF), BETA * D_MODEL ** -0.5),
        'w_down': nrm(ks[18], (DEPTH, D_FF, D_MODEL), BETA * D_FF ** -0.5),
        'ln2_g': 1.0 + nrm(ks[19], (DEPTH, D_MODEL), 0.02),
        'ln2_b': nrm(ks[20], (DEPTH, D_MODEL), 0.02),
    }


def reference(x_prompt, x_sample, c_prompt, c_sample, w_ada, b_ada, w_in, lambda_q1, lambda_k1,
              lambda_q2, lambda_k2, subln_g, w_fourier, w_out, ln1_g, ln1_b, w_gate, w_up, w_down,
              ln2_g, ln2_b):
    y_prompt = x_prompt
    y_sample = x_sample
    for l in range(DEPTH):
        y_prompt = _layer(y_prompt, c_prompt, l, w_ada, b_ada, w_in, lambda_q1, lambda_k1, lambda_q2,
                          lambda_k2, subln_g, w_fourier, w_out, ln1_g, ln1_b, w_gate, w_up, w_down,
                          ln2_g, ln2_b)
        y_sample = _layer(y_sample, c_sample, l, w_ada, b_ada, w_in, lambda_q1, lambda_k1, lambda_q2,
                          lambda_k2, subln_g, w_fourier, w_out, ln1_g, ln1_b, w_gate, w_up, w_down,
                          ln2_g, ln2_b)
    return (y_prompt, y_sample)
```

```cpp
#include <hip/hip_runtime.h>
#include <hip/hip_cooperative_groups.h>
#include <cstdio>
#include <cstdint>
#include <cmath>
namespace cg = cooperative_groups;

constexpr int DM = 1024, NTOK = 65536, TOKP = 32768, SEQ_P = 2048, SEQ_S = 16384, NBATCH = 18, DFF = 2816, NMOD = 6 * DM;
constexpr float LN_EPS = 1e-5f;
constexpr float ALPHA_C = 1.189207115002721f;
constexpr float LAMBDA_INIT = 0.2f;
constexpr size_t MiB = 1u << 20;
constexpr size_t WS_WIN = 0, WS_WOUT = 4 * MiB, WS_WGU = 6 * MiB, WS_WDN = 17 * MiB, WS_WFD = 23 * MiB, WS_MOD = 24 * MiB, WS_DFT = 25 * MiB, WS_ROPE = 26 * MiB;
constexpr size_t WS_STAT = 30 * MiB;
constexpr size_t WS_H1 = 32 * MiB, WS_X = 160 * MiB;
constexpr size_t WS_Y1 = 32 * MiB;
constexpr size_t WS_Q = 288 * MiB;
constexpr size_t WS_YP = 544 * MiB;
constexpr size_t WS_A = 288 * MiB;
constexpr size_t WS_MIX = 672 * MiB;
constexpr size_t WS_END = 800 * MiB;
constexpr size_t WS_BAR = 800 * MiB;
constexpr int LDS_BYTES = 139264;

typedef unsigned short bf16_t;
#define LAS __attribute__((address_space(3)))
__device__ __forceinline__ int opaque_tid() { int t = threadIdx.x; asm volatile("" : "+v"(t)); return t; }
namespace pg8 {
#define PG8_LAS __attribute__((address_space(3)))
typedef unsigned short bf16_t;
typedef short bf16x8 __attribute__((ext_vector_type(8)));
typedef float f32x4 __attribute__((ext_vector_type(4)));
typedef unsigned u32x4 __attribute__((ext_vector_type(4)));
constexpr int BM = 256, BK = 64, HALF = 128, HTB = HALF * BK * 2  , STAGE_BYTES = 8 * HTB, NXCD = 8, WGM = 8;

__host__ __device__ __forceinline__ int lds_byte(int r, int c) { const int st = (r >> 4) * 2 + (c >> 5), rr = r & 15, cc = c & 31, ob = rr * 64 + cc * 2; return st * 1024 + (ob ^ (((ob >> 9) & 1) << 5)); }
__host__ __device__ __forceinline__ void stage_rc(int b, int& R, int& C) { const int st = b / 1024, sb = b % 1024, swz = sb ^ (((sb >> 9) & 1) << 5); R = (st >> 1) * 16 + swz / 64; C = (st & 1) * 32 + (swz % 64) / 2; }
__host__ __device__ __forceinline__ int perm32(int rho) { const int n = rho >> 4, i = rho & 15; return 8 * (i >> 2) + 4 * n + (i & 3); }

struct Unit { int pm, pn; };
struct Gemm { const bf16_t* A; const bf16_t* Bt; int M, N, K; int ld = 0; int kwin = 0; };

struct StaticOrder {
    int nM, nN, nwg, G, c;
    __host__ __device__ void init(int M, int N, int G_, int c_) { nM = M / BM; nN = N / BM; nwg = nM * nN; G = G_; c = c_; }
    __host__ __device__ bool next(int i, Unit& u) const {
        const long L = (long)i * G + c; if (L >= nwg) return false;
        int wgid = (int)L; { const int q = nwg / NXCD, r = nwg % NXCD, xcd = wgid % NXCD, off = wgid / NXCD; wgid = (xcd < r ? xcd * (q + 1) : r * (q + 1) + (xcd - r) * q) + off; }
        const int nig = WGM * nN, gid = wgid / nig, fm = gid * WGM, gsz = (nM - fm) < WGM ? (nM - fm) : WGM;
        u.pm = fm + ((wgid % nig) % gsz); u.pn = (wgid % nig) / gsz; return true;
    }
    __device__ __forceinline__ void a_ready(const Unit&) const {}
    __device__ __forceinline__ void done(const Unit&) const {}
};

__device__ __forceinline__ unsigned cvt_pk_bf16(float lo, float hi) { unsigned r; asm volatile("v_cvt_pk_bf16_f32 %0, %1, %2" : "=v"(r) : "v"(lo), "v"(hi)); return r; }
typedef float f32x2 __attribute__((ext_vector_type(2)));
typedef unsigned u32x2 __attribute__((ext_vector_type(2)));
struct EpiPlain {
    static constexpr bool PERM = true, AFTER_DRAIN = false;
    bf16_t* O; int ldc; int coff;
    __device__ __forceinline__ void operator()(const f32x4 (&acc)[2][2][4][2], const Unit& u, int wr, int wc, int fr, int fq) const {
        const int row0 = u.pm * BM + wr * 64 + fr; const int col0 = coff + u.pn * BM + wc * 32 + 8 * fq;
#pragma unroll
        for (int ai = 0; ai < 2; ++ai)
#pragma unroll
            for (int m = 0; m < 4; ++m) { bf16_t* rowp = O + (size_t)(row0 + ai * HALF + m * 16) * ldc + col0;
#pragma unroll
                for (int bj = 0; bj < 2; ++bj) { const f32x4 v0 = acc[ai][bj][m][0], v1 = acc[ai][bj][m][1];
                    u32x4 w; w.x = cvt_pk_bf16(v0[0], v0[1]); w.y = cvt_pk_bf16(v0[2], v0[3]); w.z = cvt_pk_bf16(v1[0], v1[1]); w.w = cvt_pk_bf16(v1[2], v1[3]);
                    *(u32x4*)(rowp + bj * HALF) = w; } }
    }
};
struct EpiInProj {
    static constexpr bool PERM = true, AFTER_DRAIN = false;
    bf16_t* qkvu; const float* rope;
    __device__ __forceinline__ void operator()(const f32x4 (&acc)[2][2][4][2], const Unit& u, int wr, int wc, int fr, int fq) const {
        const int row0 = u.pm * BM + wr * 64 + fr; const int region = u.pn >> 1; const int colt = (u.pn & 1) * BM + wc * 32 + 8 * fq;
        bf16_t* base = qkvu + (size_t)region * ((size_t)65536 * 512);
#pragma unroll
        for (int ai = 0; ai < 2; ++ai)
#pragma unroll
            for (int m = 0; m < 4; ++m) { const int row = row0 + ai * HALF + m * 16; const int s = row < 32768 ? (row & 2047) : (row & 16383);
                bf16_t* rowp = base + (size_t)row * 512;
#pragma unroll
                for (int bj = 0; bj < 2; ++bj) { const int col0 = colt + bj * HALF; const f32x4 v0 = acc[ai][bj][m][0], v1 = acc[ai][bj][m][1];
                    if (region < 2) {
                        const int g64 = col0 >> 6, j = (col0 & 63) >> 3;
                        const f32x4 cs = *(const f32x4*)(rope + (size_t)s * 64 + 4 * j), sn = *(const f32x4*)(rope + (size_t)s * 64 + 32 + 4 * j);
                        const float qs = (region == 0) ? 0.18033688011112042f : 1.0f;
                        const f32x4 o1 = (v0 * cs - v1 * sn) * qs, o2 = (v1 * cs + v0 * sn) * qs;
                        u32x2 w1, w2; w1.x = cvt_pk_bf16(o1[0], o1[1]); w1.y = cvt_pk_bf16(o1[2], o1[3]); w2.x = cvt_pk_bf16(o2[0], o2[1]); w2.y = cvt_pk_bf16(o2[2], o2[3]);
                        *(u32x2*)(rowp + g64 * 64 + 4 * j) = w1; *(u32x2*)(rowp + g64 * 64 + 32 + 4 * j) = w2;
                    } else {
                        u32x4 w; w.x = cvt_pk_bf16(v0[0], v0[1]); w.y = cvt_pk_bf16(v0[2], v0[3]); w.z = cvt_pk_bf16(v1[0], v1[1]); w.w = cvt_pk_bf16(v1[2], v1[3]);
                        *(u32x4*)(rowp + col0) = w; }
                } }
    }
};
struct EpiGateUp {
    static constexpr bool PERM = true, AFTER_DRAIN = false;
    bf16_t* A;
    __device__ __forceinline__ void operator()(const f32x4 (&acc)[2][2][4][2], const Unit& u, int wr, int wc, int fr, int fq) const {
        const int row0 = u.pm * BM + wr * 64 + fr; const int p0 = u.pn * BM + wc * 32 + 8 * fq;
#pragma unroll
        for (int ai = 0; ai < 2; ++ai)
#pragma unroll
            for (int m = 0; m < 4; ++m) { bf16_t* rowp = A + (size_t)(row0 + ai * HALF + m * 16) * 2816;
#pragma unroll
                for (int bj = 0; bj < 2; ++bj) { const f32x4 g = acc[ai][bj][m][0], up = acc[ai][bj][m][1]; f32x4 o;
#pragma unroll
                    for (int e = 0; e < 4; ++e) { const float sg = __builtin_amdgcn_rcpf(1.0f + __builtin_amdgcn_exp2f(-1.4426950408889634f * g[e])); o[e] = g[e] * sg * up[e]; }
                    u32x2 w; w.x = cvt_pk_bf16(o[0], o[1]); w.y = cvt_pk_bf16(o[2], o[3]);
                    *(u32x2*)(rowp + ((p0 + bj * HALF) >> 1)) = w; } }
    }
};
struct EpiResid {
    static constexpr bool PERM = true, AFTER_DRAIN = false;
    const float* xa; const float* xb; float* out; const float* gate;
    __device__ __forceinline__ void operator()(const f32x4 (&acc)[2][2][4][2], const Unit& u, int wr, int wc, int fr, int fq) const {
        const int row0 = u.pm * BM + wr * 64 + fr; const int col0 = u.pn * BM + wc * 32 + 8 * fq;
        const int rb = u.pm * BM; const int bi = rb < 32768 ? (rb >> 11) : 16 + ((rb - 32768) >> 14);
        f32x4 gv[2][2];
#pragma unroll
        for (int bj = 0; bj < 2; ++bj)
#pragma unroll
            for (int n = 0; n < 2; ++n) gv[bj][n] = *(const f32x4*)(gate + (size_t)bi * 6144 + col0 + bj * HALF + 4 * n) + 1.0f;
#pragma unroll
        for (int ai = 0; ai < 2; ++ai)
#pragma unroll
            for (int m = 0; m < 4; ++m) { const int row = row0 + ai * HALF + m * 16;
                const float* xr = (row < 32768 ? xa + (size_t)row * 1024 : xb + (size_t)(row - 32768) * 1024) + col0; float* orow = out + (size_t)row * 1024 + col0;
#pragma unroll
                for (int bj = 0; bj < 2; ++bj)
#pragma unroll
                    for (int n = 0; n < 2; ++n) { const f32x4 xv = *(const f32x4*)(xr + bj * HALF + 4 * n);
                        *(f32x4*)(orow + bj * HALF + 4 * n) = xv * 1.189207115002721f + gv[bj][n] * acc[ai][bj][m][n]; } }
    }
};
struct EpiResidBf {
    static constexpr bool PERM = true, AFTER_DRAIN = false;
    const float* xa; const float* xb; bf16_t* out; const float* gate;
    __device__ __forceinline__ void operator()(const f32x4 (&acc)[2][2][4][2], const Unit& u, int wr, int wc, int fr, int fq) const {
        const int row0 = u.pm * BM + wr * 64 + fr; const int col0 = u.pn * BM + wc * 32 + 8 * fq;
        const int rb = u.pm * BM; const int bi = rb < 32768 ? (rb >> 11) : 16 + ((rb - 32768) >> 14);
        f32x4 gv[2][2];
#pragma unroll
        for (int bj = 0; bj < 2; ++bj)
#pragma unroll
            for (int n = 0; n < 2; ++n) gv[bj][n] = *(const f32x4*)(gate + (size_t)bi * 6144 + col0 + bj * HALF + 4 * n) + 1.0f;
#pragma unroll
        for (int ai = 0; ai < 2; ++ai)
#pragma unroll
            for (int m = 0; m < 4; ++m) { const int row = row0 + ai * HALF + m * 16;
                const float* xr = (row < 32768 ? xa + (size_t)row * 1024 : xb + (size_t)(row - 32768) * 1024) + col0; bf16_t* orow = out + (size_t)row * 1024 + col0;
#pragma unroll
                for (int bj = 0; bj < 2; ++bj) { const f32x4 x0 = *(const f32x4*)(xr + bj * HALF), x1 = *(const f32x4*)(xr + bj * HALF + 4);
                    const f32x4 v0 = x0 * 1.189207115002721f + gv[bj][0] * acc[ai][bj][m][0], v1 = x1 * 1.189207115002721f + gv[bj][1] * acc[ai][bj][m][1];
                    u32x4 w; w.x = cvt_pk_bf16(v0[0], v0[1]); w.y = cvt_pk_bf16(v0[2], v0[3]); w.z = cvt_pk_bf16(v1[0], v1[1]); w.w = cvt_pk_bf16(v1[2], v1[3]);
                    *(u32x4*)(orow + bj * HALF) = w; } }
    }
};
struct EpiResidLn {
    static constexpr bool PERM = true, AFTER_DRAIN = false;
    const bf16_t* y1; const float* stats; const float* lg; const float* lb; float* out; const float* gate;
    __device__ __forceinline__ void operator()(const f32x4 (&acc)[2][2][4][2], const Unit& u, int wr, int wc, int fr, int fq) const {
        const int row0 = u.pm * BM + wr * 64 + fr; const int col0 = u.pn * BM + wc * 32 + 8 * fq;
        const int rb = u.pm * BM; const int bi = rb < 32768 ? (rb >> 11) : 16 + ((rb - 32768) >> 14);
        f32x4 gv[2][2], lgv[2][2], lbv[2][2];
#pragma unroll
        for (int bj = 0; bj < 2; ++bj)
#pragma unroll
            for (int n = 0; n < 2; ++n) { gv[bj][n] = *(const f32x4*)(gate + (size_t)bi * 6144 + col0 + bj * HALF + 4 * n) + 1.0f;
                lgv[bj][n] = *(const f32x4*)(lg + col0 + bj * HALF + 4 * n) * 1.189207115002721f; lbv[bj][n] = *(const f32x4*)(lb + col0 + bj * HALF + 4 * n) * 1.189207115002721f; }
#pragma unroll
        for (int ai = 0; ai < 2; ++ai)
#pragma unroll
            for (int m = 0; m < 4; ++m) { const int row = row0 + ai * HALF + m * 16;
                const float mean = stats[2 * row], rstd = stats[2 * row + 1];
                const bf16_t* yr = y1 + (size_t)row * 1024 + col0; float* orow = out + (size_t)row * 1024 + col0;
#pragma unroll
                for (int bj = 0; bj < 2; ++bj)
#pragma unroll
                    for (int n = 0; n < 2; ++n) { const u32x2 yw = *(const u32x2*)(yr + bj * HALF + 4 * n);
                        const f32x4 yv = {__builtin_bit_cast(float, yw.x << 16), __builtin_bit_cast(float, yw.x & 0xffff0000u), __builtin_bit_cast(float, yw.y << 16), __builtin_bit_cast(float, yw.y & 0xffff0000u)};
                        *(f32x4*)(orow + bj * HALF + 4 * n) = (yv - mean) * rstd * lgv[bj][n] + lbv[bj][n] + gv[bj][n] * acc[ai][bj][m][n]; } }
    }
};
template <class Epi, class Sched, bool ALIGN_EPI = false, bool SP2 = false>
__device__ __forceinline__ void gemm_phase(PG8_LAS unsigned char* lds, const Gemm g, const Sched& S, const Epi& E) {
    const int tid = opaque_tid(), wid = __builtin_amdgcn_readfirstlane(tid >> 6), lane = tid & 63, wr = wid >> 2, wc = wid & 3, fr = lane & 15, fq = lane >> 4;
    const int K = g.K, nt = K / BK, LD = g.ld ? g.ld : g.K; const size_t kwb = g.kwin ? (size_t)g.K * 2 : 0;
    unsigned voffA[2], voffB[2];
#pragma unroll
    for (int i = 0; i < 2; ++i) { int R, C; stage_rc(tid * 16 + i * 8192, R, C); const int Rb = Epi::PERM ? ((R & ~31) + perm32(R & 31)) : R;
        voffA[i] = (unsigned)(R * LD + C) * 2u; voffB[i] = (unsigned)(Rb * LD + C) * 2u; }
    const size_t kstep = (size_t)(BK * 2);
    const size_t hstep = (size_t)HALF * LD * 2;
    const size_t tstep = 2 * hstep;
    const unsigned ldsw = (unsigned)wid * 1024u;
    const int aoff = lds_byte(wr * 64 + fr, fq * 8), boff = lds_byte(wc * 32 + fr, fq * 8);
#define PG8_SA(b, h) (((b) * 2 + (h)) * HTB)
#define PG8_SB(b, h) ((4 + (b) * 2 + (h)) * HTB)
#define PG8_STAGE(bufoff, gbase, voff) do { _Pragma("unroll") for (int _i = 0; _i < 2; ++_i) \
        __builtin_amdgcn_global_load_lds((const unsigned*)((const char*)(gbase) + (voff)[_i]), (PG8_LAS unsigned*)(lds + (bufoff) + ldsw + _i * 8192), 16, 0, 0); } while (0)
#define PG8_LDA(dst, b, h) do { _Pragma("unroll") for (int m = 0; m < 4; ++m) _Pragma("unroll") for (int k = 0; k < 2; ++k) dst[m][k] = *(const PG8_LAS bf16x8*)(lds + PG8_SA(b, h) + aoff + m * 2048 + k * 1024); } while (0)
#define PG8_LDB(dst, b, h) do { _Pragma("unroll") for (int n = 0; n < 2; ++n) _Pragma("unroll") for (int k = 0; k < 2; ++k) dst[n][k] = *(const PG8_LAS bf16x8*)(lds + PG8_SB(b, h) + boff + n * 2048 + k * 1024); } while (0)
#define PG8_MMA(ai, bj, At, Bt) do { __builtin_amdgcn_s_setprio(1); _Pragma("unroll") for (int m = 0; m < 4; ++m) _Pragma("unroll") for (int n = 0; n < 2; ++n) _Pragma("unroll") for (int k = 0; k < 2; ++k) \
        acc[ai][bj][m][n] = __builtin_amdgcn_mfma_f32_16x16x32_bf16(Bt[n][k], At[m][k], acc[ai][bj][m][n], 0, 0, 0); __builtin_amdgcn_s_setprio(0); } while (0)
#define PG8_WAIT_V(n) asm volatile("s_waitcnt vmcnt(" #n ")" ::: "memory")
#define PG8_WAIT_L(n) asm volatile("s_waitcnt lgkmcnt(" #n ")" ::: "memory")
#define PG8_BAR __builtin_amdgcn_s_barrier()
#define PG8_SCHED __builtin_amdgcn_sched_barrier(0)
    Unit cur, nxt; int ui = 0;
    if (!S.next(0, cur)) return;
    f32x4 acc[2][2][4][2];
#pragma unroll
    for (int a = 0; a < 2; ++a)
#pragma unroll
        for (int b = 0; b < 2; ++b)
#pragma unroll
            for (int m = 0; m < 4; ++m)
#pragma unroll
                for (int n = 0; n < 2; ++n) acc[a][b][m][n] = (f32x4){0.f, 0.f, 0.f, 0.f};
    bf16x8 At[4][2], B0[2][2], B1[2][2];
    const char* cA = (const char*)g.A + (size_t)cur.pm * tstep + (size_t)cur.pn * kwb; const char* cB = (const char*)g.Bt + (size_t)cur.pn * tstep + (size_t)cur.pn * kwb;
    S.a_ready(cur);
    if constexpr (SP2) {
        PG8_STAGE(PG8_SB(0, 0), cB, voffB); PG8_STAGE(PG8_SB(0, 1), cB + hstep, voffB); PG8_STAGE(PG8_SA(0, 0), cA, voffA); PG8_STAGE(PG8_SA(0, 1), cA + hstep, voffA);
        if (wr == 1) PG8_BAR;
        PG8_WAIT_V(2); PG8_BAR;
        PG8_STAGE(PG8_SB(1, 0), cB + kstep, voffB); PG8_STAGE(PG8_SA(1, 0), cA + kstep, voffA); PG8_STAGE(PG8_SB(1, 1), cB + hstep + kstep, voffB);
        PG8_WAIT_V(6); PG8_BAR;
    } else {
        PG8_STAGE(PG8_SB(0, 0), cB, voffB); PG8_STAGE(PG8_SA(0, 0), cA, voffA); PG8_STAGE(PG8_SB(0, 1), cB + hstep, voffB); PG8_STAGE(PG8_SA(0, 1), cA + hstep, voffA);
        if (wr == 1) PG8_BAR;
        PG8_WAIT_V(4); PG8_BAR;
        PG8_STAGE(PG8_SB(1, 0), cB + kstep, voffB); PG8_STAGE(PG8_SA(1, 0), cA + kstep, voffA); PG8_STAGE(PG8_SB(1, 1), cB + hstep + kstep, voffB);
        PG8_WAIT_V(6); PG8_BAR;
    }
    for (;;) {
        const bool has_next = S.next(ui + 1, nxt);
        const char* nA = has_next ? (const char*)g.A + (size_t)nxt.pm * tstep + (size_t)nxt.pn * kwb : cA; const char* nB = has_next ? (const char*)g.Bt + (size_t)nxt.pn * tstep + (size_t)nxt.pn * kwb : cB;
        for (int t = 0; t < nt; t += 2) {
            const bool last = (t == nt - 2);
            const char* a1 = cA + (size_t)(t + 1) * kstep;
            const char* a2 = last ? nA : cA + (size_t)(t + 2) * kstep; const char* b2 = last ? nB : cB + (size_t)(t + 2) * kstep;
            const char* a3 = a2 + kstep; const char* b3 = b2 + kstep;
            if (last && has_next) S.a_ready(nxt);
            if constexpr (SP2) {
            PG8_LDB(B0, 0, 0); PG8_LDB(B1, 0, 1); PG8_SCHED; PG8_LDA(At, 0, 0); PG8_STAGE(PG8_SA(1, 1), a1 + hstep, voffA);
            PG8_WAIT_V(8); PG8_WAIT_L(0); PG8_BAR; PG8_MMA(0, 0, At, B0); PG8_MMA(0, 1, At, B1); PG8_BAR; PG8_SCHED;
            PG8_LDA(At, 0, 1); PG8_STAGE(PG8_SB(0, 0), b2, voffB); PG8_STAGE(PG8_SB(0, 1), b2 + hstep, voffB); PG8_STAGE(PG8_SA(0, 0), a2, voffA);
            PG8_WAIT_V(8); PG8_WAIT_L(0); PG8_BAR; PG8_MMA(1, 0, At, B0); PG8_MMA(1, 1, At, B1); PG8_BAR; PG8_SCHED;
            PG8_LDB(B0, 1, 0); PG8_LDB(B1, 1, 1); PG8_SCHED; PG8_LDA(At, 1, 0); PG8_STAGE(PG8_SA(0, 1), a2 + hstep, voffA);
            PG8_WAIT_V(8); PG8_WAIT_L(0); PG8_BAR; PG8_MMA(0, 0, At, B0); PG8_MMA(0, 1, At, B1); PG8_BAR; PG8_SCHED;
            PG8_LDA(At, 1, 1); PG8_STAGE(PG8_SB(1, 0), b3, voffB); PG8_STAGE(PG8_SB(1, 1), b3 + hstep, voffB); PG8_STAGE(PG8_SA(1, 0), a3, voffA);
            PG8_WAIT_V(8); PG8_WAIT_L(0); PG8_BAR; PG8_MMA(1, 0, At, B0); PG8_MMA(1, 1, At, B1); PG8_BAR; PG8_SCHED;
            } else {
            PG8_LDB(B0, 0, 0); PG8_SCHED; PG8_LDA(At, 0, 0); PG8_STAGE(PG8_SA(1, 1), a1 + hstep, voffA);
            PG8_WAIT_L(8); PG8_BAR; PG8_WAIT_L(0); PG8_MMA(0, 0, At, B0); PG8_BAR; PG8_SCHED;
            PG8_LDB(B1, 0, 1); PG8_STAGE(PG8_SB(0, 0), b2, voffB);
            PG8_BAR; PG8_WAIT_L(0); PG8_MMA(0, 1, At, B1); PG8_BAR;
            PG8_LDA(At, 0, 1); PG8_STAGE(PG8_SA(0, 0), a2, voffA);
            PG8_BAR; PG8_WAIT_L(0); PG8_MMA(1, 0, At, B0); PG8_BAR; PG8_SCHED;
            PG8_STAGE(PG8_SB(0, 1), b2 + hstep, voffB);
            PG8_WAIT_V(6); PG8_BAR; PG8_MMA(1, 1, At, B1); PG8_BAR;
            PG8_LDB(B0, 1, 0); PG8_SCHED; PG8_LDA(At, 1, 0); PG8_STAGE(PG8_SA(0, 1), a2 + hstep, voffA);
            PG8_WAIT_L(8); PG8_BAR; PG8_WAIT_L(0); PG8_MMA(0, 0, At, B0); PG8_BAR; PG8_SCHED;
            PG8_LDB(B1, 1, 1); PG8_STAGE(PG8_SB(1, 0), b3, voffB);
            PG8_BAR; PG8_WAIT_L(0); PG8_MMA(0, 1, At, B1); PG8_BAR;
            PG8_LDA(At, 1, 1); PG8_STAGE(PG8_SA(1, 0), a3, voffA);
            PG8_BAR; PG8_WAIT_L(0); PG8_MMA(1, 0, At, B0); PG8_BAR; PG8_SCHED;
            PG8_STAGE(PG8_SB(1, 1), b3 + hstep, voffB);
            PG8_WAIT_V(6); PG8_BAR; PG8_MMA(1, 1, At, B1); PG8_BAR;
            }
        }
        if constexpr (ALIGN_EPI) { if (wr == 0) PG8_BAR; }
        if constexpr (!Epi::AFTER_DRAIN) { E(acc, cur, wr, wc, fr, fq); S.done(cur); }
        if (!has_next) break;
#pragma unroll
        for (int a = 0; a < 2; ++a)
#pragma unroll
            for (int b = 0; b < 2; ++b)
#pragma unroll
                for (int m = 0; m < 4; ++m)
#pragma unroll
                    for (int n = 0; n < 2; ++n) acc[a][b][m][n] = (f32x4){0.f, 0.f, 0.f, 0.f};
        cur = nxt; cA = nA; cB = nB; ++ui;
        if constexpr (ALIGN_EPI) { if (wr == 1) PG8_BAR; }
    }
    PG8_WAIT_V(0);
    if constexpr (!ALIGN_EPI) { if (wr == 0) PG8_BAR; }
    PG8_BAR;
    if constexpr (Epi::AFTER_DRAIN) { E.fused(acc, cur, wr, wc, fr, fq, lds, wid, lane); S.done(cur); }
#undef PG8_SA
#undef PG8_SB
#undef PG8_STAGE
#undef PG8_LDA
#undef PG8_LDB
#undef PG8_MMA
#undef PG8_WAIT_V
#undef PG8_WAIT_L
#undef PG8_BAR
#undef PG8_SCHED
}
}
namespace att {
using bf16x8 = __attribute__((ext_vector_type(8))) short;
using s16x4  = __attribute__((ext_vector_type(4))) short;
using f32x16 = __attribute__((ext_vector_type(16))) float;
using u32x4  = __attribute__((ext_vector_type(4))) unsigned;
constexpr int KVBLK = 64, LDK = 512;
constexpr float SCALE = 0.125f;
constexpr float THR = 8.f;
constexpr int SHM_V = 16384, SHM_K = 16384;
#define KSWZ(row, colB) ((row) * 256 + ((colB) ^ (((row) & 15) << 4)))
#define SBAR() __builtin_amdgcn_sched_barrier(0)
__device__ __forceinline__ int crow(int r, int hi) { return (r & 3) + 8 * (r >> 2) + 4 * hi; }
__device__ __forceinline__ unsigned cvtpk(float lo, float hi) { unsigned r; asm volatile("v_cvt_pk_bf16_f32 %0, %1, %2" : "=v"(r) : "v"(lo), "v"(hi)); return r; }

__device__ __forceinline__ void partialSM(f32x16& p0, f32x16& p1, float& m_reg, float& mn, float& alpha) {
  constexpr float C = SCALE * 1.4426950408889634f;
  float pmax = p0[0];
#pragma unroll
  for (int r = 1; r < 16; ++r) pmax = fmaxf(pmax, p0[r]);
#pragma unroll
  for (int r = 0; r < 16; ++r) pmax = fmaxf(pmax, p1[r]);
  { auto rr = __builtin_amdgcn_permlane32_swap(__float_as_uint(pmax), __float_as_uint(pmax), false, false);
    pmax = fmaxf(__uint_as_float(rr[0]), __uint_as_float(rr[1])); }
  if (__builtin_expect(__all(pmax - m_reg <= THR / SCALE), 1)) { mn = m_reg; alpha = 1.f; }
  else { mn = fmaxf(m_reg, pmax); alpha = __builtin_amdgcn_exp2f((m_reg - mn) * C); m_reg = mn; }
  float mnC = -mn * C;
#pragma unroll
  for (int r = 0; r < 16; ++r) p0[r] = fmaf(p0[r], C, mnC);
#pragma unroll
  for (int r = 0; r < 16; ++r) p1[r] = fmaf(p1[r], C, mnC);
#pragma unroll
  for (int r = 0; r < 16; ++r) p0[r] = __builtin_amdgcn_exp2f(p0[r]);
}
__device__ __forceinline__ void finishSM(f32x16& p0, f32x16& p1, float alpha, float& l_reg, bf16x8& pa0, bf16x8& pa1, bf16x8& pa2, bf16x8& pa3) {
#pragma unroll
  for (int r = 0; r < 16; ++r) p1[r] = __builtin_amdgcn_exp2f(p1[r]);
  float ps = 0;
#pragma unroll
  for (int r = 0; r < 16; ++r) ps += p0[r];
#pragma unroll
  for (int r = 0; r < 16; ++r) ps += p1[r];
  { auto rr = __builtin_amdgcn_permlane32_swap(__float_as_uint(ps), __float_as_uint(ps), false, false);
    ps = __uint_as_float(rr[0]) + __uint_as_float(rr[1]); }
  l_reg = l_reg * alpha + ps;
#define PK4(P, BASE, OUT) do { unsigned a0 = cvtpk(P[BASE + 0], P[BASE + 1]), a1 = cvtpk(P[BASE + 2], P[BASE + 3]);   \
    unsigned b0 = cvtpk(P[BASE + 4], P[BASE + 5]), b1 = cvtpk(P[BASE + 6], P[BASE + 7]);                              \
    auto r0 = __builtin_amdgcn_permlane32_swap(a0, b0, false, false); auto r1 = __builtin_amdgcn_permlane32_swap(a1, b1, false, false); \
    u32x4 w = {r0[0], r1[0], r0[1], r1[1]}; OUT = *reinterpret_cast<bf16x8*>(&w); } while (0)
  PK4(p0, 0, pa0); PK4(p0, 8, pa1); PK4(p1, 0, pa2); PK4(p1, 8, pa3);
#undef PK4
}
__device__ __forceinline__ void qkt(f32x16& p0, f32x16& p1, const char* Ks, const bf16x8* qr, int r32, int hi, int cmap) {
  p0 = f32x16{}; p1 = f32x16{};
#pragma unroll
  for (int d0 = 0; d0 < 4; ++d0) { int cb = (cmap * 64 + d0 * 16 + hi * 8) * 2;
    bf16x8 b0 = *reinterpret_cast<const bf16x8*>(Ks + KSWZ(r32, cb));
    bf16x8 b1 = *reinterpret_cast<const bf16x8*>(Ks + KSWZ(32 + r32, cb));
    p0 = __builtin_amdgcn_mfma_f32_32x32x16_bf16(b0, qr[d0], p0, 0, 0, 0);
    p1 = __builtin_amdgcn_mfma_f32_32x32x16_bf16(b1, qr[d0], p1, 0, 0, 0); }
}
__device__ __forceinline__ void qkt_load(bf16x8 (&kf)[8], const char* Ks, int r32, int hi, int cmap) {
#pragma unroll
  for (int d0 = 0; d0 < 4; ++d0) { int cb = (cmap * 64 + d0 * 16 + hi * 8) * 2;
    kf[2 * d0] = *reinterpret_cast<const bf16x8*>(Ks + KSWZ(r32, cb)); kf[2 * d0 + 1] = *reinterpret_cast<const bf16x8*>(Ks + KSWZ(32 + r32, cb)); }
}
__device__ __forceinline__ void qkt_mma(f32x16& p0, f32x16& p1, const bf16x8 (&kf)[8], const bf16x8* qr) {
  p0 = f32x16{}; p1 = f32x16{};
#pragma unroll
  for (int d0 = 0; d0 < 4; ++d0) { p0 = __builtin_amdgcn_mfma_f32_32x32x16_bf16(kf[2 * d0], qr[d0], p0, 0, 0, 0); p1 = __builtin_amdgcn_mfma_f32_32x32x16_bf16(kf[2 * d0 + 1], qr[d0], p1, 0, 0, 0); }
}
__device__ __forceinline__ int v_st(int k, int c) { const int kk = (k & ~0xC) | ((k & 4) << 1) | ((k & 8) >> 1); return ((kk >> 3) * 4 + (c >> 5)) * 512 + ((kk & 7) * 32 + (c & 31)) * 2; }
__device__ __forceinline__ int v_rd_base(int lane) { return ((lane & 3) << 3) | (((lane >> 2) & 3) << 6) | (((lane >> 4) & 1) << 5) | (((lane >> 5) & 1) << 8); }
constexpr int v_rd_off(int d0, int ks, int half) { return d0 * 512 + ks * 4096 + half * 2048; }
template <int OFF> __device__ __forceinline__ s16x4 tr_read(int vb) {
  s16x4 r; asm volatile("ds_read_b64_tr_b16 %0, %1 offset:%2" : "=&v"(r) : "v"(vb), "i"(OFF) : "memory"); return r;
}
struct VF { s16x4 l0, h0, l1, h1, l2, h2, l3, h3; };
template <int D0> __device__ __forceinline__ void vf_issue(VF& f, int vb) {
  f.l0 = tr_read<v_rd_off(D0, 0, 0)>(vb); f.h0 = tr_read<v_rd_off(D0, 0, 1)>(vb); f.l1 = tr_read<v_rd_off(D0, 1, 0)>(vb); f.h1 = tr_read<v_rd_off(D0, 1, 1)>(vb);
  f.l2 = tr_read<v_rd_off(D0, 2, 0)>(vb); f.h2 = tr_read<v_rd_off(D0, 2, 1)>(vb); f.l3 = tr_read<v_rd_off(D0, 3, 0)>(vb); f.h3 = tr_read<v_rd_off(D0, 3, 1)>(vb);
}
#define PKF(L, H) (bf16x8){L[0], L[1], L[2], L[3], H[0], H[1], H[2], H[3]}
#define MMA4(od, f) do { od = __builtin_amdgcn_mfma_f32_32x32x16_bf16(pa0, PKF(f.l0, f.h0), od, 0, 0, 0); od = __builtin_amdgcn_mfma_f32_32x32x16_bf16(pa1, PKF(f.l1, f.h1), od, 0, 0, 0); \
    od = __builtin_amdgcn_mfma_f32_32x32x16_bf16(pa2, PKF(f.l2, f.h2), od, 0, 0, 0); od = __builtin_amdgcn_mfma_f32_32x32x16_bf16(pa3, PKF(f.l3, f.h3), od, 0, 0, 0); } while (0)
#define PIN(x) asm volatile("" : "+v"(x))
#define WAIT_LGKM(n) asm volatile("s_waitcnt lgkmcnt(" #n ")" ::: "memory")
__device__ __forceinline__ float sm_rowmax(const f32x16& p0, const f32x16& p1) {
  float pmax = p0[0];
#pragma unroll
  for (int r = 1; r < 16; ++r) pmax = fmaxf(pmax, p0[r]);
#pragma unroll
  for (int r = 0; r < 16; ++r) pmax = fmaxf(pmax, p1[r]);
  auto rr = __builtin_amdgcn_permlane32_swap(__float_as_uint(pmax), __float_as_uint(pmax), false, false);
  return fmaxf(__uint_as_float(rr[0]), __uint_as_float(rr[1]));
}
__device__ __forceinline__ void sm_scale(f32x16& p0, f32x16& p1, float pmax, float& m_reg, float& alpha, bool& zero) {
  constexpr float THR2 = THR * 1.4426950408889634f;
  alpha = 1.f;
  if (__builtin_expect(!__all(pmax - m_reg <= THR2), 0)) { const float mn = fmaxf(m_reg, pmax); alpha = __builtin_amdgcn_exp2f(m_reg - mn); m_reg = mn; zero = false; }
  if (__builtin_expect(!zero, 0)) {
#pragma unroll
    for (int r = 0; r < 16; ++r) { p0[r] -= m_reg; p1[r] -= m_reg; }
  }
}
__device__ __forceinline__ void sm_exp(f32x16& p) {
#pragma unroll
  for (int r = 0; r < 16; ++r) p[r] = __builtin_amdgcn_exp2f(p[r]);
}
__device__ __forceinline__ void sm_finish(const f32x16& p0, const f32x16& p1, float alpha, float& l_reg, bf16x8& pa0, bf16x8& pa1, bf16x8& pa2, bf16x8& pa3) {
  float ps = 0;
#pragma unroll
  for (int r = 0; r < 16; ++r) ps += p0[r];
#pragma unroll
  for (int r = 0; r < 16; ++r) ps += p1[r];
  { auto rr = __builtin_amdgcn_permlane32_swap(__float_as_uint(ps), __float_as_uint(ps), false, false);
    ps = __uint_as_float(rr[0]) + __uint_as_float(rr[1]); }
  l_reg = l_reg * alpha + ps;
#define PK8(P, BASE, OUT) do { u32x4 w = {cvtpk(P[BASE + 0], P[BASE + 1]), cvtpk(P[BASE + 2], P[BASE + 3]), cvtpk(P[BASE + 4], P[BASE + 5]), cvtpk(P[BASE + 6], P[BASE + 7])}; \
    OUT = *reinterpret_cast<bf16x8*>(&w); } while (0)
  PK8(p0, 0, pa0); PK8(p0, 8, pa1); PK8(p1, 0, pa2); PK8(p1, 8, pa3);
#undef PK8
}
__device__ __forceinline__ unsigned short f2bf(float f) { unsigned u = __builtin_bit_cast(unsigned, f); return (unsigned short)((u + 0x7fffu + ((u >> 16) & 1u)) >> 16); }

__device__ __forceinline__ float sm_rowsum(const f32x16& p0, const f32x16& p1) {
  float ps = 0;
#pragma unroll
  for (int r = 0; r < 16; ++r) ps += p0[r];
#pragma unroll
  for (int r = 0; r < 16; ++r) ps += p1[r];
  auto rr = __builtin_amdgcn_permlane32_swap(__float_as_uint(ps), __float_as_uint(ps), false, false);
  return __uint_as_float(rr[0]) + __uint_as_float(rr[1]);
}
__device__ __forceinline__ void sm_pack(const f32x16& p0, const f32x16& p1, bf16x8& pa0, bf16x8& pa1, bf16x8& pa2, bf16x8& pa3) {
#define PK8(P, BASE, OUT) do { u32x4 w = {cvtpk(P[BASE + 0], P[BASE + 1]), cvtpk(P[BASE + 2], P[BASE + 3]), cvtpk(P[BASE + 4], P[BASE + 5]), cvtpk(P[BASE + 6], P[BASE + 7])}; \
    OUT = *reinterpret_cast<bf16x8*>(&w); } while (0)
  PK8(p0, 0, pa0); PK8(p0, 8, pa1); PK8(p1, 0, pa2); PK8(p1, 8, pa3);
#undef PK8
}
template <int LO, int HI> __device__ __forceinline__ void sm_exp_rng(f32x16& p0, f32x16& p1) {
#pragma unroll
  for (int i = LO; i < HI; ++i) { if (i < 16) p0[i] = __builtin_amdgcn_exp2f(p0[i]); else p1[i - 16] = __builtin_amdgcn_exp2f(p1[i - 16]); }
}
__device__ __forceinline__ void glds16(const void* gsrc, unsigned lds_dst) { unsigned keep;
  asm volatile("s_mov_b32 %0, m0\n\ts_mov_b32 m0, %2\n\ts_nop 0\n\tglobal_load_lds_dwordx4 %1, off\n\ts_mov_b32 m0, %0" : "=&s"(keep) : "v"(gsrc), "s"(lds_dst) : "memory"); }
#define WAIT_BAR(N) asm volatile("s_waitcnt vmcnt(" #N ") lgkmcnt(0)\n\ts_barrier" ::: "memory")
template <bool FAST>
__device__ __forceinline__ bool attn_unit(const bf16_t* __restrict__ Qb, const bf16_t* __restrict__ Kh, const bf16_t* __restrict__ Vh,
                                          bf16_t* __restrict__ Ob, int seq, char* lds, float lam, const float* __restrict__ subg) {
  const int tid = opaque_tid(), wid = tid >> 6, lane = tid & 63, r32 = lane & 31, hi = lane >> 5;
  const int qg = wid & 3, cmap = wid >> 2;
  constexpr int BUFB = 32768;
  float* ws = (float*)(lds + 4 * BUFB) + wid * 64; float* li_l = ws; float* al_l = ws + 32;
  float m_reg = 0.f, l_reg = 0; bool zero = true; f32x16 o[4] = {}; bf16x8 qr[4];
  const bf16_t* Qw = Qb + (long)(qg * 32 + r32) * LDK + cmap * 64 + hi * 8;
#pragma unroll
  for (int d0 = 0; d0 < 4; ++d0) qr[d0] = *reinterpret_cast<const bf16x8*>(Qw + d0 * 16);
  const unsigned lds0 = (unsigned)(uintptr_t)lds;
  const int vb0 = (int)lds0 + v_rd_base(lane);
  int koff[2], voff[2];
#pragma unroll
  for (int i = 0; i < 2; ++i) { const int c = wid + 8 * i;
    { const int row = 4 * c + (lane >> 4), sch = (lane & 15) ^ (row & 15); koff[i] = row * LDK + sch * 8; }
    { const int st = 2 * c + (lane >> 5), kk = (st >> 2) * 8 + ((lane & 31) >> 2), k = kk, col = (st & 3) * 32 + (lane & 3) * 8; voff[i] = k * LDK + col; } }
  const unsigned dstw = lds0 + (unsigned)wid * 1024u;
#define DMA_TILE(t, boff) do { const bf16_t* kt_ = Kh + (long)(t) * (KVBLK * LDK); const bf16_t* vt_ = Vh + (long)(t) * (KVBLK * LDK); \
    const unsigned d_ = (unsigned)__builtin_amdgcn_readfirstlane((int)(dstw + (unsigned)(boff))); \
    glds16(kt_ + koff[0], d_ + 16384u); glds16(kt_ + koff[1], d_ + 16384u + 8192u); glds16(vt_ + voff[0], d_); glds16(vt_ + voff[1], d_ + 8192u); } while (0)
#define RESC(a) do { if (__any((a) < 1.f)) { if (hi == 0) al_l[r32] = (a); asm volatile("s_waitcnt lgkmcnt(0)" ::: "memory"); \
    _Pragma("unroll") for (int d = 0; d < 4; ++d) _Pragma("unroll") for (int r = 0; r < 16; ++r) o[d][r] *= al_l[crow(r, hi)]; } } while (0)
  f32x16 pA0, pA1, pB0, pB1; float alA, alB; bf16x8 pa0, pa1, pa2, pa3; const int NT = seq / KVBLK;
  int kv_prev = 0, kv_cur = BUFB, kv_n1 = 2 * BUFB, kv_n2 = 3 * BUFB;
  asm volatile("s_waitcnt vmcnt(0)" ::: "memory");
  DMA_TILE(0, 0); DMA_TILE(1, BUFB); DMA_TILE(2, 2 * BUFB);
  WAIT_BAR(8);
  qkt(pA0, pA1, lds + 16384, qr, r32, hi, cmap);
  alA = 1.f; alB = 1.f;
  if constexpr (FAST) { sm_exp(pA0); sm_exp(pA1); }
  else { const float pm = sm_rowmax(pA0, pA1);
    if (!__all(fabsf(pm) <= THR * 1.4426950408889634f)) { m_reg = pm; zero = false; }
    if (!zero) {
#pragma unroll
      for (int r = 0; r < 16; ++r) { pA0[r] -= m_reg; pA1[r] -= m_reg; } }
    sm_exp(pA0); sm_exp(pA1); }
  WAIT_BAR(4);
#define STEP_SLOW(C0, C1, P0, P1, alC, alP, LDCOND, LDT) do { \
    const bool ld_ = (LDCOND); if (ld_) DMA_TILE(LDT, kv_n2); SBAR(); \
    const int vb = vb0 + kv_prev; VF fa, fb; \
    vf_issue<0>(fa, vb); SBAR(); \
    qkt(C0, C1, lds + kv_cur + 16384, qr, r32, hi, cmap); \
    sm_finish(P0, P1, alP, l_reg, pa0, pa1, pa2, pa3); SBAR(); \
    vf_issue<1>(fb, vb); WAIT_LGKM(8); SBAR(); \
    MMA4(o[0], fa); float pm_ = sm_rowmax(C0, C1); PIN(pm_); SBAR(); \
    vf_issue<2>(fa, vb); WAIT_LGKM(8); SBAR(); \
    MMA4(o[1], fb); sm_scale(C0, C1, pm_, m_reg, alC, zero); PIN(C0); PIN(C1); SBAR(); \
    vf_issue<3>(fb, vb); WAIT_LGKM(8); SBAR(); \
    MMA4(o[2], fa); sm_exp(C0); PIN(C0); SBAR(); \
    WAIT_LGKM(0); SBAR(); \
    MMA4(o[3], fb); sm_exp(C1); PIN(C1); SBAR(); \
    RESC(alC); \
    if (ld_) WAIT_BAR(4); else WAIT_BAR(0); \
    { const int t_ = kv_prev; kv_prev = kv_cur; kv_cur = kv_n1; kv_n1 = kv_n2; kv_n2 = t_; } } while (0)
#define STEP_FAST(C0, C1, P0, P1, LDCOND, LDT) do { \
    const bool ld_ = (LDCOND); if (ld_) DMA_TILE(LDT, kv_n2); SBAR(); \
    const int vb = vb0 + kv_prev; VF fa, fb; \
    vf_issue<0>(fa, vb); SBAR(); \
    bf16x8 kf_[8]; qkt_load(kf_, lds + kv_cur + 16384, r32, hi, cmap); SBAR(); \
    l_reg += sm_rowsum(P0, P1); PIN(l_reg); SBAR();                \
    qkt_mma(C0, C1, kf_, qr); sm_pack(P0, P1, pa0, pa1, pa2, pa3); SBAR(); \
    vf_issue<1>(fb, vb); WAIT_LGKM(8); SBAR(); \
    MMA4(o[0], fa); sm_exp_rng<0, 8>(C0, C1); PIN(C0); SBAR(); \
    vf_issue<2>(fa, vb); WAIT_LGKM(8); SBAR(); \
    MMA4(o[1], fb); sm_exp_rng<8, 16>(C0, C1); PIN(C0); SBAR(); \
    vf_issue<3>(fb, vb); WAIT_LGKM(8); SBAR(); \
    MMA4(o[2], fa); sm_exp_rng<16, 24>(C0, C1); PIN(C1); SBAR(); \
    WAIT_LGKM(0); SBAR(); \
    MMA4(o[3], fb); sm_exp_rng<24, 32>(C0, C1); PIN(C1); SBAR(); \
    if (ld_) WAIT_BAR(4); else WAIT_BAR(0); \
    { const int t_ = kv_prev; kv_prev = kv_cur; kv_cur = kv_n1; kv_n1 = kv_n2; kv_n2 = t_; } } while (0)
#define STEP(C0, C1, P0, P1, alC, alP, LDCOND, LDT) do { if constexpr (FAST) STEP_FAST(C0, C1, P0, P1, LDCOND, LDT); else STEP_SLOW(C0, C1, P0, P1, alC, alP, LDCOND, LDT); } while (0)
  for (int j = 1; j + 1 < NT; j += 2) {
    STEP(pB0, pB1, pA0, pA1, alB, alA, (j + 2 < NT), j + 2);
    STEP(pA0, pA1, pB0, pB1, alA, alB, (j + 3 < NT), j + 3);
  }
  STEP(pB0, pB1, pA0, pA1, alB, alA, false, 0);
  {
    const int vb = vb0 + kv_prev; VF fa, fb;
    vf_issue<0>(fa, vb); SBAR();
    if constexpr (FAST) { l_reg += sm_rowsum(pB0, pB1); sm_pack(pB0, pB1, pa0, pa1, pa2, pa3); } else sm_finish(pB0, pB1, alB, l_reg, pa0, pa1, pa2, pa3);
    SBAR();
    vf_issue<1>(fb, vb); WAIT_LGKM(8); SBAR(); MMA4(o[0], fa); SBAR();
    vf_issue<2>(fa, vb); WAIT_LGKM(8); SBAR(); MMA4(o[1], fb); SBAR();
    vf_issue<3>(fb, vb); WAIT_LGKM(8); SBAR(); MMA4(o[2], fa); SBAR();
    WAIT_LGKM(0); SBAR(); MMA4(o[3], fb); SBAR();
  }
#undef STEP
#undef STEP_FAST
#undef STEP_SLOW
#undef DMA_TILE
  if constexpr (FAST) {
    const bool okw = __all(l_reg < 1.8446744e19f && l_reg > 5.4210109e-20f);
    if (lane == 0) li_l[63] = okw ? 1.f : 0.f;
    __syncthreads();
    bool ok = true;
#pragma unroll
    for (int w = 0; w < 8; ++w) ok = ok && (((const float*)(lds + 4 * BUFB))[w * 64 + 63] != 0.f);
    if (!ok) { __syncthreads(); return false; }
  }
  if (hi == 0) li_l[r32] = l_reg; asm volatile("s_waitcnt lgkmcnt(0)" ::: "memory");
  float rli[16];
#pragma unroll
  for (int r = 0; r < 16; ++r) rli[r] = __builtin_amdgcn_rcpf(li_l[crow(r, hi)]);
  __syncthreads();
  float* XB = (float*)lds + qg * (32 * 128);
  if (cmap == 1) {
#pragma unroll
    for (int r = 0; r < 16; ++r)
#pragma unroll
      for (int d0 = 0; d0 < 4; ++d0) XB[crow(r, hi) * 128 + d0 * 32 + r32] = o[d0][r] * rli[r] * (-lam);
  }
  __syncthreads();
  if (cmap == 0) {
    float gsc[4];
#pragma unroll
    for (int d0 = 0; d0 < 4; ++d0) gsc[d0] = subg[d0 * 32 + r32] * (1.0f - 0.2f);
#pragma unroll
    for (int r = 0; r < 16; ++r) { float v[4]; float ss = 0.f;
#pragma unroll
      for (int d0 = 0; d0 < 4; ++d0) { v[d0] = o[d0][r] * rli[r] + XB[crow(r, hi) * 128 + d0 * 32 + r32]; ss += v[d0] * v[d0]; }
      ss += __shfl_xor(ss, 1); ss += __shfl_xor(ss, 2); ss += __shfl_xor(ss, 4); ss += __shfl_xor(ss, 8); ss += __shfl_xor(ss, 16);
      const float rs = 1.0f / sqrtf(ss * (1.0f / 128.0f) + 1e-5f);
      bf16_t* orow = Ob + (long)(qg * 32 + crow(r, hi)) * 1024 + r32;
#pragma unroll
      for (int d0 = 0; d0 < 4; ++d0) orow[d0 * 32] = f2bf(v[d0] * rs * gsc[d0]); }
  }
  __syncthreads();
#undef RESC
  return true;
}
#undef KSWZ
#undef SBAR
}
struct Params { const float* in[21]; float* out; unsigned char* ws; float inv_freq[32]; };
enum { I_XP = 0, I_XS, I_CP, I_CS, I_WADA, I_BADA, I_WIN, I_LQ1, I_LK1, I_LQ2, I_LK2, I_SUBG, I_WF, I_WOUT, I_LN1G, I_LN1B, I_WG, I_WU, I_WD, I_LN2G, I_LN2B };

typedef float f32x4 __attribute__((ext_vector_type(4)));
typedef float f32x16 __attribute__((ext_vector_type(16)));
typedef short bf16x8 __attribute__((ext_vector_type(8)));
typedef short s16x4 __attribute__((ext_vector_type(4)));
typedef unsigned u32x4 __attribute__((ext_vector_type(4)));
typedef unsigned u32x2 __attribute__((ext_vector_type(2)));
#define LDS_WAIT() asm volatile("s_waitcnt lgkmcnt(0)" ::: "memory")

__device__ __forceinline__ unsigned f2bf(float f) { unsigned u = __builtin_bit_cast(unsigned, f); return (u + 0x7fffu + ((u >> 16) & 1u)) >> 16; }
__device__ __forceinline__ unsigned pk2(float lo, float hi) { return f2bf(lo) | (f2bf(hi) << 16); }
__device__ __forceinline__ float bf2f(unsigned short h) { return __builtin_bit_cast(float, (unsigned)h << 16); }
__device__ __forceinline__ float wave_sum(float v) {
#pragma unroll
    for (int o = 1; o < 64; o <<= 1) v += __shfl_xor(v, o);
    return v;
}
__device__ __forceinline__ int batch_of_row(int row) { return row < TOKP ? (row >> 11) : 16 + ((row - TOKP) >> 14); }

template <int MODE> __device__ __forceinline__ const float* src_col(const float* W0, const float* W1, int N0, int p, int& ldn) {
    if (MODE == 0) { ldn = N0; return W0 + p; }
    if (MODE == 1) { ldn = N0; int s = p;
        if (p < 1024) { const int w = p & 511, g64 = w >> 6, r = w & 63, j = r >> 3, e = r & 7; const int d = (e < 4) ? (4 * j + e) : (32 + 4 * j + (e - 4)); s = (p & ~511) + g64 * 64 + d; }
        return W0 + s; }
    { ldn = N0; const int g8 = p >> 3, e = p & 7; return (e < 4) ? (W0 + 4 * g8 + e) : (W1 + 4 * g8 + (e - 4)); }
}
template <int MODE> __device__ __forceinline__ void transpose_item(const float* W0, const float* W1, int K, int N0, int Np, bf16_t* WT, LAS float* scr, int item, int lane) {
    const int nblk = Np / 32, kb = item / nblk, nb = item % nblk, k0 = 64 * kb, n0 = 32 * nb;
    int ldn; const float* src = src_col<MODE>(W0, W1, N0, n0 + (lane & 31), ldn);
#pragma unroll 8
    for (int i = 0; i < 32; ++i) { const int kk = 2 * i + (lane >> 5); scr[kk * 33 + (lane & 31)] = src[(size_t)(k0 + kk) * ldn]; }
    LDS_WAIT(); asm volatile("" ::: "memory");
    const int c = lane & 7;
#pragma unroll
    for (int j = 0; j < 4; ++j) { const int n = (lane >> 3) + 8 * j; const LAS float* s = scr + (8 * c) * 33 + n;
        u32x4 o; o.x = pk2(s[0 * 33], s[1 * 33]); o.y = pk2(s[2 * 33], s[3 * 33]); o.z = pk2(s[4 * 33], s[5 * 33]); o.w = pk2(s[6 * 33], s[7 * 33]);
        *(u32x4*)(WT + (size_t)(n0 + n) * K + k0 + 8 * c) = o; }
    LDS_WAIT(); asm volatile("" ::: "memory");
}
__device__ __forceinline__ void sincos_acc(float ang, float& sn, float& cs) {
    const double x = (double)ang; const double n = __builtin_rint(x * 0.63661977236758134308);
    double r = __builtin_fma(-n, 1.57079632679489655800e+00, x); r = __builtin_fma(-n, 6.12323399573676603587e-17, r);
    const double r2 = r * r;
    const double sp = r2 * (-1.0 / 6 + r2 * (1.0 / 120 + r2 * (-1.0 / 5040 + r2 * (1.0 / 362880 + r2 * (-1.0 / 39916800 + r2 * (1.0 / 6227020800.0 + r2 * (-1.0 / 1307674368000.0)))))));
    const double ss = r + r * sp;
    const double cp = r2 * (-0.5 + r2 * (1.0 / 24 + r2 * (-1.0 / 720 + r2 * (1.0 / 40320 + r2 * (-1.0 / 3628800 + r2 * (1.0 / 479001600.0 + r2 * (-1.0 / 87178291200.0 + r2 * (1.0 / 20922789888000.0))))))));
    const double cc = 1.0 + cp; const int q = ((int)n) & 3;
    const double s_ = (q == 0) ? ss : (q == 1) ? cc : (q == 2) ? -ss : -cc;
    const double c_ = (q == 0) ? cc : (q == 1) ? -ss : (q == 2) ? -cc : ss;
    sn = (float)s_; cs = (float)c_;
}

__device__ __forceinline__ void p0_prologue(const Params& P, unsigned char* lds) {
    const int tid = threadIdx.x, lane = tid & 63, wave = tid >> 6, G = gridDim.x, bid = blockIdx.x;
    unsigned char* ws = P.ws;
    if (bid < 96) {
        float* sl = (float*)lds; float* red = sl + NBATCH * 1024;
        for (int i = tid; i < NBATCH * 1024; i += 512) { const int bi = i >> 10, d = i & 1023; const float c = bi < 16 ? P.in[I_CP][bi * 1024 + d] : P.in[I_CS][(bi - 16) * 1024 + d];
            sl[i] = c / (1.0f + __expf(-c)); }
        __syncthreads();
        for (int unit = bid; unit < 96; unit += G) {
            const int el = tid & 63, ds = tid >> 6, e = unit * 64 + el; float acc[NBATCH];
#pragma unroll
            for (int b = 0; b < NBATCH; ++b) acc[b] = 0.f;
            const float* wa = P.in[I_WADA] + e;
            for (int d = ds * 128; d < ds * 128 + 128; ++d) { const float w = wa[(size_t)d * NMOD];
#pragma unroll
                for (int b = 0; b < NBATCH; ++b) acc[b] += sl[b * 1024 + d] * w; }
#pragma unroll
            for (int b = 0; b < NBATCH; ++b) red[(ds * NBATCH + b) * 64 + el] = acc[b];
            __syncthreads();
            for (int o = tid; o < NBATCH * 64; o += 512) { const int b = o >> 6, e2 = o & 63; float s = P.in[I_BADA][unit * 64 + e2];
#pragma unroll
                for (int d2 = 0; d2 < 8; ++d2) s += red[(d2 * NBATCH + b) * 64 + e2];
                ((float*)(ws + WS_MOD))[b * NMOD + unit * 64 + e2] = s; }
            __syncthreads();
        }
    }
    __syncthreads();
    {
        LAS float* scr = (LAS float*)((LAS unsigned char*)lds + wave * 16384);
        const int gw = bid * 8 + wave, NGW = G * 8;
        constexpr int I_IN = (1024 / 64) * (2048 / 32), I_OUT = (1024 / 64) * (1024 / 32), I_GU = (1024 / 64) * (5632 / 32), I_DN = (2816 / 64) * (1024 / 32);
        for (int it = gw; it < I_IN + I_OUT + I_GU + I_DN; it += NGW) {
            int r = it;
            if (r < I_IN) { transpose_item<1>(P.in[I_WIN], nullptr, 1024, 2048, 2048, (bf16_t*)(ws + WS_WIN), scr, r, lane); continue; } r -= I_IN;
            if (r < I_OUT) { transpose_item<0>(P.in[I_WOUT], nullptr, 1024, 1024, 1024, (bf16_t*)(ws + WS_WOUT), scr, r, lane); continue; } r -= I_OUT;
            if (r < I_GU) { transpose_item<2>(P.in[I_WG], P.in[I_WU], 1024, 2816, 5632, (bf16_t*)(ws + WS_WGU), scr, r, lane); continue; } r -= I_GU;
            transpose_item<0>(P.in[I_WD], nullptr, 2816, 1024, 1024, (bf16_t*)(ws + WS_WDN), scr, r, lane);
        }
    }
    const int gt = bid * 512 + tid, NGT = G * 512;
    for (int i = gt; i < SEQ_S * 32; i += NGT) { const int s = i >> 5, k = i & 31; const float ang = (float)s * P.inv_freq[k]; float sn, cs; sincos_acc(ang, sn, cs);
        float* rp = (float*)(ws + WS_ROPE) + (size_t)s * 64; rp[k] = cs; rp[32 + k] = sn; }
    for (int i = gt; i < 128 * 128; i += NGT) { const int k = i >> 7, n = i & 127; const float fr = (float)((k * n) & 127) * (1.0f / 128.0f);
        const float c = __builtin_amdgcn_cosf(fr), s = __builtin_amdgcn_sinf(fr); bf16_t* t = (bf16_t*)(ws + WS_DFT);
        t[i] = (bf16_t)f2bf(c); t[16384 + i] = (bf16_t)f2bf(s); t[32768 + i] = (bf16_t)f2bf(-s); }
    for (int i = gt; i < 512 * 1024; i += NGT) { const int n = i >> 10, k = i & 1023, g = n >> 7, c = n & 127, g2 = k >> 8, ri = (k >> 7) & 1, c1 = k & 127; float v = 0.f;
        if (g == g2) { const float* wf = P.in[I_WF] + (size_t)g * 16384 + c; float a = 0.f;
            for (int j = 0; j < 128; ++j) { const float fr = (float)((c1 * j) & 127) * (1.0f / 128.0f); const float t = ri ? __builtin_amdgcn_sinf(fr) : __builtin_amdgcn_cosf(fr); a += t * wf[j * 128]; }
            v = a * 0.08838834764831845f; }
        ((bf16_t*)(ws + WS_WFD))[i] = (bf16_t)f2bf(v); }
}

__device__ __forceinline__ void ln_stats(f32x4 (&v)[4], float& mean, float& rstd) {
    float s = 0.f;
#pragma unroll
    for (int j = 0; j < 4; ++j) s += (v[j].x + v[j].y) + (v[j].z + v[j].w);
    mean = wave_sum(s) * (1.f / DM); float s2 = 0.f;
#pragma unroll
    for (int j = 0; j < 4; ++j) { v[j] = v[j] - mean; s2 += (v[j].x * v[j].x + v[j].y * v[j].y) + (v[j].z * v[j].z + v[j].w * v[j].w); }
    rstd = 1.f / sqrtf(wave_sum(s2) * (1.f / DM) + LN_EPS);
}
constexpr int RW = 4;
__device__ __forceinline__ void p1_lnmod(const Params& P) {
    const int lane = threadIdx.x & 63, gw = blockIdx.x * 8 + (threadIdx.x >> 6), NGW = gridDim.x * 8;
    const float* mod = (const float*)(P.ws + WS_MOD); bf16_t* H = (bf16_t*)(P.ws + WS_H1);
    for (int rb = gw * RW; rb < NTOK; rb += NGW * RW) {
        const float* mb = mod + (size_t)batch_of_row(rb) * NMOD;
        f32x4 v[RW][4]; float rstd[RW];
#pragma unroll
        for (int q = 0; q < RW; ++q) { const int row = rb + q; const float* xr = row < TOKP ? P.in[I_XP] + (size_t)row * DM : P.in[I_XS] + (size_t)(row - TOKP) * DM;
#pragma unroll
            for (int j = 0; j < 4; ++j) v[q][j] = ((const f32x4*)xr)[lane + 64 * j]; }
        f32x4 sh[4], sc[4];
#pragma unroll
        for (int j = 0; j < 4; ++j) { sh[j] = ((const f32x4*)mb)[lane + 64 * j]; sc[j] = ((const f32x4*)(mb + 1024))[lane + 64 * j] + 1.0f; }
#pragma unroll
        for (int q = 0; q < RW; ++q) { float mean; ln_stats(v[q], mean, rstd[q]); }
#pragma unroll
        for (int q = 0; q < RW; ++q) { unsigned long long* o8 = (unsigned long long*)(H + (size_t)(rb + q) * DM) + lane;
#pragma unroll
            for (int j = 0; j < 4; ++j) { const f32x4 h = v[q][j] * rstd[q] * sc[j] + sh[j];
                o8[64 * j] = (unsigned long long)pk2(h.x, h.y) | ((unsigned long long)pk2(h.z, h.w) << 32); } }
    }
}
__device__ __forceinline__ void p5_ln1(const Params& P) {
    const int lane = threadIdx.x & 63, gw = blockIdx.x * 8 + (threadIdx.x >> 6), NGW = gridDim.x * 8;
    const float* mod = (const float*)(P.ws + WS_MOD); bf16_t* H = (bf16_t*)(P.ws + WS_MIX); const bf16_t* Y = (const bf16_t*)(P.ws + WS_Y1);
    for (int rb = gw * RW; rb < NTOK; rb += NGW * RW) {
        const float* mb = mod + (size_t)batch_of_row(rb) * NMOD;
        f32x4 v[RW][4]; float rstd[RW];
#pragma unroll
        for (int q = 0; q < RW; ++q) { const bf16_t* yr = Y + (size_t)(rb + q) * DM;
#pragma unroll
            for (int j = 0; j < 4; ++j) { const u32x2 yw = ((const u32x2*)yr)[lane + 64 * j];
                v[q][j] = (f32x4){__builtin_bit_cast(float, yw.x << 16), __builtin_bit_cast(float, yw.x & 0xffff0000u), __builtin_bit_cast(float, yw.y << 16), __builtin_bit_cast(float, yw.y & 0xffff0000u)}; } }
#pragma unroll
        for (int q = 0; q < RW; ++q) { float mean; ln_stats(v[q], mean, rstd[q]); if (lane == 0) { float* st = (float*)(P.ws + WS_STAT) + 2 * (size_t)(rb + q); st[0] = mean; st[1] = rstd[q]; } }
#pragma unroll
        for (int j = 0; j < 4; ++j) { const f32x4 g = ((const f32x4*)P.in[I_LN1G])[lane + 64 * j], b = ((const f32x4*)P.in[I_LN1B])[lane + 64 * j];
#pragma unroll
            for (int q = 0; q < RW; ++q) v[q][j] = v[q][j] * rstd[q] * g + b; }
#pragma unroll
        for (int q = 0; q < RW; ++q) { float mean; ln_stats(v[q], mean, rstd[q]); }
#pragma unroll
        for (int j = 0; j < 4; ++j) { const f32x4 sh = ((const f32x4*)(mb + 3072))[lane + 64 * j], sc = ((const f32x4*)(mb + 4096))[lane + 64 * j] + 1.0f;
#pragma unroll
            for (int q = 0; q < RW; ++q) { const f32x4 h = v[q][j] * rstd[q] * sc + sh;
                ((unsigned long long*)(H + (size_t)(rb + q) * DM))[lane + 64 * j] = (unsigned long long)pk2(h.x, h.y) | ((unsigned long long)pk2(h.z, h.w) << 32); } }
    }
}
__device__ __forceinline__ void p8_ln2(const Params& P) {
    const int lane = threadIdx.x & 63, gw = blockIdx.x * 8 + (threadIdx.x >> 6), NGW = gridDim.x * 8;
    for (int rb = gw * RW; rb < NTOK; rb += NGW * RW) {
        f32x4 v[RW][4]; float rstd[RW];
#pragma unroll
        for (int q = 0; q < RW; ++q) { const float* zr = P.out + (size_t)(rb + q) * DM;
#pragma unroll
            for (int j = 0; j < 4; ++j) v[q][j] = ((const f32x4*)zr)[lane + 64 * j]; }
#pragma unroll
        for (int q = 0; q < RW; ++q) { float mean; ln_stats(v[q], mean, rstd[q]); }
#pragma unroll
        for (int j = 0; j < 4; ++j) { const f32x4 g = ((const f32x4*)P.in[I_LN2G])[lane + 64 * j], b = ((const f32x4*)P.in[I_LN2B])[lane + 64 * j];
#pragma unroll
            for (int q = 0; q < RW; ++q) ((f32x4*)(P.out + (size_t)(rb + q) * DM))[lane + 64 * j] = v[q][j] * rstd[q] * g + b; }
    }
}

constexpr int FPB = 576;
typedef short v4i16_t __attribute__((ext_vector_type(4)));
__device__ __forceinline__ bf16x8 fft_bfrag(const LAS unsigned char* p) {
    const s16x4 lo = __builtin_bit_cast(s16x4, __builtin_amdgcn_ds_read_tr16_b64_v4i16((LAS v4i16_t*)p));
    const s16x4 hi = __builtin_bit_cast(s16x4, __builtin_amdgcn_ds_read_tr16_b64_v4i16((LAS v4i16_t*)(p + 4 * FPB)));
    return (bf16x8){lo[0], lo[1], lo[2], lo[3], hi[0], hi[1], hi[2], hi[3]};
}
__device__ __forceinline__ int crow16(int r, int hi) { return (r & 3) + 8 * (r >> 2) + 4 * hi; }

__device__ __forceinline__ void fa_sample_tile(const Params& P, unsigned char* lds, int tile) {
    const int tid = threadIdx.x, lane = tid & 63, wid = tid >> 6, r32 = lane & 31, hi = lane >> 5;
    const int g = tile & 3, n2p = (tile >> 2) & 63, b = tile >> 8;
    const bf16_t* U = (const bf16_t*)(P.ws + WS_Q) + (size_t)3 * NTOK * 512; bf16_t* YP = (bf16_t*)(P.ws + WS_YP);
    const size_t tok0 = (size_t)TOKP + (size_t)b * SEQ_S;
#pragma unroll
    for (int i = 0; i < 8; ++i) { const int c = tid + 512 * i, n1 = c >> 5, w = c & 31, t2 = w >> 4, c8 = w & 15;
        const u32x4 v = *(const u32x4*)(U + (tok0 + 128 * n1 + 2 * n2p + t2) * 512 + g * 128 + c8 * 8);
        *(u32x4*)(lds + n1 * FPB + (t2 * 128 + c8 * 8) * 2) = v; }
    __syncthreads();
    const int wm = wid & 3, wn = wid >> 2;
    const bf16_t* Wc = (const bf16_t*)(P.ws + WS_DFT); const bf16_t* Wn = Wc + 32768;
    const LAS unsigned char* lb = (const LAS unsigned char*)lds + (8 * hi + ((lane & 15) >> 2)) * FPB + (16 * ((lane >> 4) & 1) + 4 * (lane & 3)) * 2 + wn * 256;
    const int n2 = 2 * n2p + wn;
#pragma unroll 1
    for (int half = 0; half < 2; ++half) {
        f32x16 ar[2] = {}, ai[2] = {};
#pragma unroll 4
        for (int kk = 0; kk < 8; ++kk) {
            const bf16x8 fc = *(const bf16x8*)(Wc + (wm * 32 + r32) * 128 + kk * 16 + 8 * hi), fn = *(const bf16x8*)(Wn + (wm * 32 + r32) * 128 + kk * 16 + 8 * hi);
#pragma unroll
            for (int nb = 0; nb < 2; ++nb) { const bf16x8 bf = fft_bfrag(lb + kk * 16 * FPB + (half * 2 + nb) * 64);
                ar[nb] = __builtin_amdgcn_mfma_f32_32x32x16_bf16(fc, bf, ar[nb], 0, 0, 0); ai[nb] = __builtin_amdgcn_mfma_f32_32x32x16_bf16(fn, bf, ai[nb], 0, 0, 0); }
        }
#pragma unroll
        for (int r = 0; r < 16; ++r) { const int k1 = wm * 32 + crow16(r, hi); const float fr = (float)(k1 * n2) * (1.0f / 16384.0f);
            const float tc = __builtin_amdgcn_cosf(fr) * (1.0f / 128.0f), ts = __builtin_amdgcn_sinf(fr) * (1.0f / 128.0f);
            bf16_t* yrow = YP + (tok0 + (size_t)k1 * 128 + n2) * 1024 + g * 256 + half * 64 + r32;
#pragma unroll
            for (int nb = 0; nb < 2; ++nb) { const float yr = ar[nb][r], yi = ai[nb][r];
                yrow[nb * 32] = (bf16_t)f2bf(yr * tc + yi * ts); yrow[128 + nb * 32] = (bf16_t)f2bf(yi * tc - yr * ts); } }
    }
    __syncthreads();
}
__device__ const float C16T[16] = {1.f, 0.9238795325112867f, 0.7071067811865476f, 0.3826834323650898f, 0.f, -0.3826834323650898f, -0.7071067811865476f, -0.9238795325112867f,
                                   -1.f, -0.9238795325112867f, -0.7071067811865476f, -0.3826834323650898f, 0.f, 0.3826834323650898f, 0.7071067811865476f, 0.9238795325112867f};
__device__ __forceinline__ void fa_prompt(const Params& P) {
    const bf16_t* U = (const bf16_t*)(P.ws + WS_Q) + (size_t)3 * NTOK * 512; bf16_t* YP = (bf16_t*)(P.ws + WS_YP);
    const int NGT = gridDim.x * 512;
    for (int it = blockIdx.x * 512 + threadIdx.x; it < 16 * 128 * 256; it += NGT) {
        const int cp = it & 255, n2 = (it >> 8) & 127, b = it >> 15; float x0[16], x1[16];
#pragma unroll
        for (int n1 = 0; n1 < 16; ++n1) { const unsigned w = *(const unsigned*)(U + ((size_t)b * SEQ_P + 128 * n1 + n2) * 512 + 2 * cp); x0[n1] = __builtin_bit_cast(float, w << 16); x1[n1] = __builtin_bit_cast(float, w & 0xffff0000u); }
        const int col = 2 * cp, g = col >> 7, ch = col & 127;
#pragma unroll
        for (int k1 = 0; k1 < 16; ++k1) { float r0 = 0.f, i0 = 0.f, r1 = 0.f, i1 = 0.f;
#pragma unroll
            for (int n1 = 0; n1 < 16; ++n1) { const float c = C16T[(k1 * n1) & 15], s = C16T[((k1 * n1) + 12) & 15]; r0 += x0[n1] * c; i0 -= x0[n1] * s; r1 += x1[n1] * c; i1 -= x1[n1] * s; }
            const float fr = (float)(k1 * n2) * (1.0f / 2048.0f); const float sc = 0.022097086912079608f;
            const float tc = __builtin_amdgcn_cosf(fr) * sc, ts = __builtin_amdgcn_sinf(fr) * sc;
            bf16_t* yrow = YP + ((size_t)b * SEQ_P + (size_t)k1 * 128 + n2) * 1024 + g * 256 + ch;
            *(unsigned*)yrow = pk2(r0 * tc + i0 * ts, r1 * tc + i1 * ts); *(unsigned*)(yrow + 128) = pk2(i0 * tc - r0 * ts, i1 * tc - r1 * ts); }
    }
}
__device__ __forceinline__ void fc_tile(const Params& P, unsigned char* lds, size_t tokb, int N1, int k1, int g) {
    const int tid = threadIdx.x, lane = tid & 63, wid = tid >> 6, r32 = lane & 31, hi = lane >> 5;
    const bf16_t* YP = (const bf16_t*)(P.ws + WS_YP); bf16_t* X = (bf16_t*)(P.ws + WS_X);
#pragma unroll
    for (int i = 0; i < 8; ++i) { const int c = tid + 512 * i, n2 = c >> 5, w = c & 31;
        const u32x4 v = *(const u32x4*)(YP + (tokb + (size_t)k1 * 128 + n2) * 1024 + g * 256 + w * 8);
        *(u32x4*)(lds + n2 * FPB + w * 16) = v; }
    __syncthreads();
    const int wm = wid & 3, wn = wid >> 2;
    const bf16_t* Wc = (const bf16_t*)(P.ws + WS_DFT); const bf16_t* Ws = Wc + 16384; const bf16_t* Wn = Wc + 32768;
    const LAS unsigned char* lb = (const LAS unsigned char*)lds + (8 * hi + ((lane & 15) >> 2)) * FPB + (16 * ((lane >> 4) & 1) + 4 * (lane & 3)) * 2 + wn * 128;
    f32x16 ar[2] = {}, ai[2] = {};
#pragma unroll 4
    for (int kk = 0; kk < 8; ++kk) { const int ao = (wm * 32 + r32) * 128 + kk * 16 + 8 * hi;
        const bf16x8 fc = *(const bf16x8*)(Wc + ao), fs = *(const bf16x8*)(Ws + ao), fn = *(const bf16x8*)(Wn + ao);
#pragma unroll
        for (int nb = 0; nb < 2; ++nb) { const bf16x8 bre = fft_bfrag(lb + kk * 16 * FPB + nb * 64), bim = fft_bfrag(lb + kk * 16 * FPB + 256 + nb * 64);
            ar[nb] = __builtin_amdgcn_mfma_f32_32x32x16_bf16(fc, bre, ar[nb], 0, 0, 0); ar[nb] = __builtin_amdgcn_mfma_f32_32x32x16_bf16(fs, bim, ar[nb], 0, 0, 0);
            ai[nb] = __builtin_amdgcn_mfma_f32_32x32x16_bf16(fc, bim, ai[nb], 0, 0, 0); ai[nb] = __builtin_amdgcn_mfma_f32_32x32x16_bf16(fn, bre, ai[nb], 0, 0, 0); }
    }
#pragma unroll
    for (int r = 0; r < 16; ++r) { const int k2 = wm * 32 + crow16(r, hi);
        bf16_t* xrow = X + (tokb + (size_t)k1 + (size_t)N1 * k2) * 1024 + g * 256 + wn * 64 + r32;
#pragma unroll
        for (int nb = 0; nb < 2; ++nb) { xrow[nb * 32] = (bf16_t)f2bf(ar[nb][r]); xrow[128 + nb * 32] = (bf16_t)f2bf(ai[nb][r]); } }
    __syncthreads();
}

#define XB_TMO      128
#define XB_XCNT(j)  (256  + 64 * (j))
#define XB_XSUB(j)  (1280 + 64 * (j))
#define XB_XGEN(j)  (2304 + 64 * (j))
#define XB_TOP      3328
#define XB_TOPGEN   3392
#define XCD_BAR_WORDS 3456
#define XB_SPIN_CAP (1u << 18)

__device__ __forceinline__ unsigned xb_ld(unsigned* p)              { return __hip_atomic_load(p, __ATOMIC_RELAXED, __HIP_MEMORY_SCOPE_AGENT); }
__device__ __forceinline__ unsigned xb_add(unsigned* p, unsigned v) { return __hip_atomic_fetch_add(p, v, __ATOMIC_RELAXED, __HIP_MEMORY_SCOPE_AGENT); }
__device__ __forceinline__ unsigned xb_xcc_id() { return (unsigned)__builtin_amdgcn_s_getreg((3 << 11) | 20) & 0xFu; }
#define XB_SPIN(cond, bar) do { unsigned _sp = 0; while (cond) { __builtin_amdgcn_s_sleep(1); \
    if ((++_sp & 255u) == 0u) { if (xb_ld(&(bar)[XB_TMO])) break; if (_sp > XB_SPIN_CAP) { atomicAdd(&(bar)[XB_TMO], 1u); break; } } } } while (0)

struct XcdBarrier {
    unsigned* bar; unsigned x;
    volatile LAS unsigned* st;
};

__device__ __forceinline__ XcdBarrier xcd_barrier_post(unsigned* bar, volatile LAS unsigned* st) {
    XcdBarrier b; b.bar = bar; b.x = xb_xcc_id(); b.st = st;
    if (threadIdx.x == 0) (void)xb_add(&bar[XB_XCNT(b.x)], 1u);
    return b;
}
__device__ __forceinline__ void xcd_barrier_complete(unsigned* bar, unsigned x, unsigned& nloc, unsigned& nx) {
    const unsigned G = gridDim.x * gridDim.y * gridDim.z;
    unsigned sum, cnt, mine, sp = 0u;
    for (;;) {
        sum = 0u; cnt = 0u; mine = 0u;
#pragma unroll
        for (unsigned j = 0; j < 16; ++j) { const unsigned c = xb_ld(&bar[XB_XCNT(j)]); sum += c; cnt += (c > 0u) ? 1u : 0u; mine = (j == x) ? c : mine; }
        if (sum == G) break;
        __builtin_amdgcn_s_sleep(1);
        if ((++sp & 255u) == 0u) { if (xb_ld(&bar[XB_TMO])) break; if (sp > XB_SPIN_CAP) { atomicAdd(&bar[XB_TMO], 1u); break; } }
    }
    nloc = mine > 0u ? mine : 1u; nx = cnt > 0u ? cnt : 1u;
}

__device__ __forceinline__ void xcd_barrier(const XcdBarrier& b) {
    asm volatile("s_waitcnt vmcnt(0)" ::: "memory");
    __syncthreads();
    if (threadIdx.x == 0) {
        unsigned* bar = b.bar;
        __builtin_amdgcn_s_waitcnt(0);
        unsigned nloc = b.st[0], nx = b.st[1];
        if (nloc == 0u) { xcd_barrier_complete(bar, b.x, nloc, nx); b.st[0] = nloc; b.st[1] = nx; }
        const unsigned old = xb_add(&bar[XB_XSUB(b.x)], 1u);
        const unsigned gen = old / nloc;
        if (old + 1u == (gen + 1u) * nloc) {
            __builtin_amdgcn_fence(__ATOMIC_RELEASE, "agent");
            asm volatile("s_waitcnt vmcnt(0)" ::: "memory");
            const unsigned og = xb_add(&bar[XB_TOP], 1u);
            const unsigned tg = og / nx;
            if (og + 1u == (tg + 1u) * nx) xb_add(&bar[XB_TOPGEN], 1u);
            else XB_SPIN(xb_ld(&bar[XB_TOPGEN]) == tg, bar);
            __builtin_amdgcn_fence(__ATOMIC_ACQUIRE, "agent");
            xb_add(&bar[XB_XGEN(b.x)], 1u);
            asm volatile("s_waitcnt vmcnt(0)" ::: "memory");
        } else {
            XB_SPIN(xb_ld(&bar[XB_XGEN(b.x)]) == gen, bar);
            __builtin_amdgcn_fence(__ATOMIC_ACQUIRE, "agent");
            asm volatile("s_waitcnt vmcnt(0)" ::: "memory");
        }
    }
    __syncthreads();
}

__device__ __forceinline__ void grid_bar(unsigned* ctr, unsigned target) {
    asm volatile("s_waitcnt vmcnt(0) lgkmcnt(0)" ::: "memory");
    __syncthreads();
    if (threadIdx.x == 0) {
        __builtin_amdgcn_fence(__ATOMIC_RELEASE, "agent");
        asm volatile("s_waitcnt vmcnt(0)" ::: "memory");
        __hip_atomic_fetch_add(ctr, 1u, __ATOMIC_RELAXED, __HIP_MEMORY_SCOPE_AGENT);
        while (__hip_atomic_load(ctr, __ATOMIC_RELAXED, __HIP_MEMORY_SCOPE_AGENT) < target) __builtin_amdgcn_s_sleep(2);
        __builtin_amdgcn_fence(__ATOMIC_ACQUIRE, "agent");
        asm volatile("s_waitcnt vmcnt(0)" ::: "memory");
    }
    __syncthreads();
}

__global__ void __launch_bounds__(512, 2) fwd_megakernel(Params P) {
    extern __shared__ __attribute__((aligned(16))) unsigned char lds[];
    cg::grid_group grid = cg::this_grid();
    unsigned char* ws = P.ws; const int G = gridDim.x, bid = blockIdx.x;
    bf16_t* Qb = (bf16_t*)(ws + WS_Q); const size_t QS = (size_t)NTOK * 512;
    const float* mod = (const float*)(ws + WS_MOD);
    volatile LAS unsigned* xst = (volatile LAS unsigned*)((LAS unsigned char*)lds + (LDS_BYTES - 64));
    if (threadIdx.x < 2) xst[threadIdx.x] = 0u;
    __syncthreads();
    const XcdBarrier xbar = xcd_barrier_post((unsigned*)(ws + WS_BAR), xst);
#define GBAR() xcd_barrier(xbar)

    p0_prologue(P, lds);
    grid.sync();
    p1_lnmod(P);
    GBAR();
#ifndef NO_PH_P2
    { pg8::Gemm g{(const bf16_t*)(ws + WS_H1), (const bf16_t*)(ws + WS_WIN), NTOK, 2048, 1024}; pg8::StaticOrder S; S.init(NTOK, 2048, G, bid);
      pg8::EpiInProj E{Qb, (const float*)(ws + WS_ROPE)};
      pg8::gemm_phase<pg8::EpiInProj, pg8::StaticOrder, true, true>((LAS unsigned char*)lds, g, S, E); }
#endif
    GBAR();
#ifndef NO_PH_FA
    for (int t = bid; t < 512; t += G) fa_sample_tile(P, lds, t);
    fa_prompt(P);
#endif
    GBAR();
#ifndef NO_PH_FC
    for (int t = bid; t < 2048; t += G) {
        if (t < 1024) { const int g = t & 3, k1 = (t >> 2) & 127, b = t >> 9; fc_tile(P, lds, (size_t)TOKP + (size_t)b * SEQ_S, 128, k1, g); }
        else { const int t2 = t - 1024, g = t2 & 3, k1 = (t2 >> 2) & 15, b = t2 >> 6; fc_tile(P, lds, (size_t)b * SEQ_P, 16, k1, g); }
    }
#endif
    GBAR();
#ifndef NO_PH_FD
    { pg8::Gemm g{(const bf16_t*)(ws + WS_X), (const bf16_t*)(ws + WS_WFD), NTOK, 512, 512, 1024, 1};     pg8::StaticOrder S; S.init(NTOK, 512, G, bid);
      pg8::EpiPlain E{(bf16_t*)(ws + WS_MIX), 1024, 512};
      pg8::gemm_phase<pg8::EpiPlain, pg8::StaticOrder, true, true>((LAS unsigned char*)lds, g, S, E); }
    __syncthreads();
#endif
#ifndef NO_PH_ATT
    {
        float lam;
        { float s1 = 0.f, s2 = 0.f;
          for (int i = 0; i < 64; ++i) { s1 += P.in[I_LQ1][i] * P.in[I_LK1][i]; s2 += P.in[I_LQ2][i] * P.in[I_LK2][i]; }
          lam = expf(s1) - expf(s2) + LAMBDA_INIT; }
        for (int idx = bid; idx < 2048; idx += G) {
            int b, h, qb, seq; size_t tok0;
            if (idx < 1024) { const int bh = idx & 7; qb = idx >> 3; b = bh >> 2; h = bh & 3; seq = SEQ_S; tok0 = (size_t)TOKP + (size_t)b * SEQ_S; }
            else { const int i2 = idx - 1024, x = i2 & 7, y = i2 >> 3; qb = y & 15; const int bh = x + 8 * (y >> 4); b = bh >> 2; h = bh & 3; seq = SEQ_P; tok0 = (size_t)b * SEQ_P; }
            const bf16_t* Qp = Qb + (tok0 + (size_t)qb * 128) * 512 + h * 128; const bf16_t* Kp = Qb + QS + tok0 * 512 + h * 128; const bf16_t* Vp = Qb + 2 * QS + tok0 * 512 + h * 128;
            bf16_t* Op = (bf16_t*)(ws + WS_MIX) + (tok0 + (size_t)qb * 128) * 1024 + h * 128;
            if (!att::attn_unit<true>(Qp, Kp, Vp, Op, seq, (char*)lds, lam, P.in[I_SUBG]))
                (void)att::attn_unit<false>(Qp, Kp, Vp, Op, seq, (char*)lds, lam, P.in[I_SUBG]);
        }
    }
#endif
    GBAR();
#ifndef NO_PH_P4
    { pg8::Gemm g{(const bf16_t*)(ws + WS_MIX), (const bf16_t*)(ws + WS_WOUT), NTOK, 1024, 1024}; pg8::StaticOrder S; S.init(NTOK, 1024, G, bid);
      pg8::EpiResidBf E{P.in[I_XP], P.in[I_XS], (bf16_t*)(ws + WS_Y1), mod + 2048};
      pg8::gemm_phase<pg8::EpiResidBf, pg8::StaticOrder, true, true>((LAS unsigned char*)lds, g, S, E); }
#endif
    GBAR();
#ifndef NO_PH_P5
    p5_ln1(P);
#endif
    GBAR();
#ifndef NO_PH_P6
    { pg8::Gemm g{(const bf16_t*)(ws + WS_MIX), (const bf16_t*)(ws + WS_WGU), NTOK, 5632, 1024}; pg8::StaticOrder S; S.init(NTOK, 5632, G, bid);
      pg8::EpiGateUp E{(bf16_t*)(ws + WS_A)};
      pg8::gemm_phase<pg8::EpiGateUp, pg8::StaticOrder, true, true>((LAS unsigned char*)lds, g, S, E); }
#endif
    GBAR();
#ifndef NO_PH_P7
    { pg8::Gemm g{(const bf16_t*)(ws + WS_A), (const bf16_t*)(ws + WS_WDN), NTOK, 1024, 2816}; pg8::StaticOrder S; S.init(NTOK, 1024, G, bid);
      pg8::EpiResidLn E{(const bf16_t*)(ws + WS_Y1), (const float*)(ws + WS_STAT), P.in[I_LN1G], P.in[I_LN1B], P.out, mod + 5120};
      pg8::gemm_phase<pg8::EpiResidLn, pg8::StaticOrder, true, true>((LAS unsigned char*)lds, g, S, E); }
#endif
    GBAR();
#ifndef NO_PH_P8
    p8_ln2(P);
#endif
}

extern "C" void kernel_launch(void* const* d_in, const int* in_sizes, int n_in, void* d_out, int out_size, void* d_ws, size_t ws_size, hipStream_t stream) {
    static int grid = 0;
    if (grid == 0) {
        if (n_in != 21 || out_size != NTOK * DM || ws_size < WS_END + 16384) { fprintf(stderr, "kernel_launch: unexpected shapes (n_in %d out %d ws %zu)\n", n_in, out_size, ws_size); grid = -1; return; }
        int dev = 0, cus = 0, per_cu = 0;
        (void)hipGetDevice(&dev); (void)hipDeviceGetAttribute(&cus, hipDeviceAttributeMultiprocessorCount, dev);
        if (hipFuncSetAttribute((const void*)fwd_megakernel, hipFuncAttributeMaxDynamicSharedMemorySize, LDS_BYTES) != hipSuccess) { fprintf(stderr, "kernel_launch: hipFuncSetAttribute failed\n"); grid = -1; return; }
        if (hipOccupancyMaxActiveBlocksPerMultiprocessor(&per_cu, (const void*)fwd_megakernel, 512, LDS_BYTES) != hipSuccess || per_cu < 1) { fprintf(stderr, "kernel_launch: occupancy query gave %d\n", per_cu); per_cu = 1; }
        (void)hipGetLastError();
        grid = cus * 1;
        if (grid <= 0) grid = 256;
    }
    if (grid < 0) return;
    Params p{};
    for (int i = 0; i < 21; ++i) p.in[i] = (const float*)d_in[i];
    p.out = (float*)d_out; p.ws = (unsigned char*)d_ws;
    for (int i = 0; i < 32; ++i) p.inv_freq[i] = (float)pow(10000.0, -(double)i / 32.0);
    (void)hipMemsetAsync((unsigned char*)d_ws + WS_BAR, 0, 16384, stream);
    void* args[] = {&p};
    hipError_t e = hipLaunchCooperativeKernel((const void*)fwd_megakernel, dim3(grid), dim3(512), args, LDS_BYTES, stream);
    if (e != hipSuccess) fprintf(stderr, "kernel_launch: cooperative launch failed: %s (grid %d)\n", hipGetErrorString(e), grid);
}
```

```cpp
#include <hip/hip_runtime.h>
#include <hip/hip_cooperative_groups.h>
#include <cstdio>
#include <cstdint>
#include <cmath>
namespace cg = cooperative_groups;

constexpr int DM = 1024, NTOK = 65536, TOKP = 32768, SEQ_P = 2048, SEQ_S = 16384, NBATCH = 18, DFF = 2816, NMOD = 6 * DM;
constexpr float LN_EPS = 1e-5f;
constexpr float ALPHA_C = 1.189207115002721f;
constexpr float LAMBDA_INIT = 0.2f;
constexpr size_t MiB = 1u << 20;
constexpr size_t WS_WIN = 0, WS_WOUT = 4 * MiB, WS_WGU = 6 * MiB, WS_WDN = 17 * MiB, WS_WFD = 23 * MiB, WS_MOD = 24 * MiB, WS_DFT = 25 * MiB, WS_ROPE = 26 * MiB;
constexpr size_t WS_STAT = 30 * MiB;
constexpr size_t WS_H1 = 32 * MiB, WS_X = 160 * MiB;
constexpr size_t WS_Y1 = 32 * MiB;
constexpr size_t WS_Q = 288 * MiB;
constexpr size_t WS_YP = 544 * MiB;
constexpr size_t WS_A = 288 * MiB;
constexpr size_t WS_MIX = 672 * MiB;
constexpr size_t WS_END = 800 * MiB;
constexpr size_t WS_BAR = 800 * MiB;
constexpr int LDS_BYTES = 139264;

typedef unsigned short bf16_t;
#define LAS __attribute__((address_space(3)))
__device__ __forceinline__ int opaque_tid() { int t = threadIdx.x; asm volatile("" : "+v"(t)); return t; }
namespace pg8 {
#define PG8_LAS __attribute__((address_space(3)))
typedef unsigned short bf16_t;
typedef short bf16x8 __attribute__((ext_vector_type(8)));
typedef float f32x4 __attribute__((ext_vector_type(4)));
typedef unsigned u32x4 __attribute__((ext_vector_type(4)));
constexpr int BM = 256, BK = 64, HALF = 128, HTB = HALF * BK * 2  , STAGE_BYTES = 8 * HTB, NXCD = 8, WGM = 8;

__host__ __device__ __forceinline__ int lds_byte(int r, int c) { const int st = (r >> 4) * 2 + (c >> 5), rr = r & 15, cc = c & 31, ob = rr * 64 + cc * 2; return st * 1024 + (ob ^ (((ob >> 9) & 1) << 5)); }
__host__ __device__ __forceinline__ void stage_rc(int b, int& R, int& C) { const int st = b / 1024, sb = b % 1024, swz = sb ^ (((sb >> 9) & 1) << 5); R = (st >> 1) * 16 + swz / 64; C = (st & 1) * 32 + (swz % 64) / 2; }
__host__ __device__ __forceinline__ int perm32(int rho) { const int n = rho >> 4, i = rho & 15; return 8 * (i >> 2) + 4 * n + (i & 3); }

struct Unit { int pm, pn; };
struct Gemm { const bf16_t* A; const bf16_t* Bt; int M, N, K; int ld = 0; int kwin = 0; };

struct StaticOrder {
    int nM, nN, nwg, G, c;
    __host__ __device__ void init(int M, int N, int G_, int c_) { nM = M / BM; nN = N / BM; nwg = nM * nN; G = G_; c = c_; }
    __host__ __device__ bool next(int i, Unit& u) const {
        const long L = (long)i * G + c; if (L >= nwg) return false;
        int wgid = (int)L; { const int q = nwg / NXCD, r = nwg % NXCD, xcd = wgid % NXCD, off = wgid / NXCD; wgid = (xcd < r ? xcd * (q + 1) : r * (q + 1) + (xcd - r) * q) + off; }
        const int nig = WGM * nN, gid = wgid / nig, fm = gid * WGM, gsz = (nM - fm) < WGM ? (nM - fm) : WGM;
        u.pm = fm + ((wgid % nig) % gsz); u.pn = (wgid % nig) / gsz; return true;
    }
    __device__ __forceinline__ void a_ready(const Unit&) const {}
    __device__ __forceinline__ void done(const Unit&) const {}
};

__device__ __forceinline__ unsigned cvt_pk_bf16(float lo, float hi) { unsigned r; asm volatile("v_cvt_pk_bf16_f32 %0, %1, %2" : "=v"(r) : "v"(lo), "v"(hi)); return r; }
typedef float f32x2 __attribute__((ext_vector_type(2)));
typedef unsigned u32x2 __attribute__((ext_vector_type(2)));
struct EpiPlain {
    static constexpr bool PERM = true, AFTER_DRAIN = false;
    bf16_t* O; int ldc; int coff;
    __device__ __forceinline__ void operator()(const f32x4 (&acc)[2][2][4][2], const Unit& u, int wr, int wc, int fr, int fq) const {
        const int row0 = u.pm * BM + wr * 64 + fr; const int col0 = coff + u.pn * BM + wc * 32 + 8 * fq;
#pragma unroll
        for (int ai = 0; ai < 2; ++ai)
#pragma unroll
            for (int m = 0; m < 4; ++m) { bf16_t* rowp = O + (size_t)(row0 + ai * HALF + m * 16) * ldc + col0;
#pragma unroll
                for (int bj = 0; bj < 2; ++bj) { const f32x4 v0 = acc[ai][bj][m][0], v1 = acc[ai][bj][m][1];
                    u32x4 w; w.x = cvt_pk_bf16(v0[0], v0[1]); w.y = cvt_pk_bf16(v0[2], v0[3]); w.z = cvt_pk_bf16(v1[0], v1[1]); w.w = cvt_pk_bf16(v1[2], v1[3]);
                    *(u32x4*)(rowp + bj * HALF) = w; } }
    }
};
struct EpiInProj {
    static constexpr bool PERM = true, AFTER_DRAIN = false;
    bf16_t* qkvu; const float* rope;
    __device__ __forceinline__ void operator()(const f32x4 (&acc)[2][2][4][2], const Unit& u, int wr, int wc, int fr, int fq) const {
        const int row0 = u.pm * BM + wr * 64 + fr; const int region = u.pn >> 1; const int colt = (u.pn & 1) * BM + wc * 32 + 8 * fq;
        bf16_t* base = qkvu + (size_t)region * ((size_t)65536 * 512);
#pragma unroll
        for (int ai = 0; ai < 2; ++ai)
#pragma unroll
            for (int m = 0; m < 4; ++m) { const int row = row0 + ai * HALF + m * 16; const int s = row < 32768 ? (row & 2047) : (row & 16383);
                bf16_t* rowp = base + (size_t)row * 512;
#pragma unroll
                for (int bj = 0; bj < 2; ++bj) { const int col0 = colt + bj * HALF; const f32x4 v0 = acc[ai][bj][m][0], v1 = acc[ai][bj][m][1];
                    if (region < 2) {
                        const int g64 = col0 >> 6, j = (col0 & 63) >> 3;
                        const f32x4 cs = *(const f32x4*)(rope + (size_t)s * 64 + 4 * j), sn = *(const f32x4*)(rope + (size_t)s * 64 + 32 + 4 * j);
                        const float qs = (region == 0) ? 0.18033688011112042f : 1.0f;
                        const f32x4 o1 = (v0 * cs - v1 * sn) * qs, o2 = (v1 * cs + v0 * sn) * qs;
                        u32x2 w1, w2; w1.x = cvt_pk_bf16(o1[0], o1[1]); w1.y = cvt_pk_bf16(o1[2], o1[3]); w2.x = cvt_pk_bf16(o2[0], o2[1]); w2.y = cvt_pk_bf16(o2[2], o2[3]);
                        *(u32x2*)(rowp + g64 * 64 + 4 * j) = w1; *(u32x2*)(rowp + g64 * 64 + 32 + 4 * j) = w2;
                    } else {
                        u32x4 w; w.x = cvt_pk_bf16(v0[0], v0[1]); w.y = cvt_pk_bf16(v0[2], v0[3]); w.z = cvt_pk_bf16(v1[0], v1[1]); w.w = cvt_pk_bf16(v1[2], v1[3]);
                        *(u32x4*)(rowp + col0) = w; }
                } }
    }
};
struct EpiGateUp {
    static constexpr bool PERM = true, AFTER_DRAIN = false;
    bf16_t* A;
    __device__ __forceinline__ void operator()(const f32x4 (&acc)[2][2][4][2], const Unit& u, int wr, int wc, int fr, int fq) const {
        const int row0 = u.pm * BM + wr * 64 + fr; const int p0 = u.pn * BM + wc * 32 + 8 * fq;
#pragma unroll
        for (int ai = 0; ai < 2; ++ai)
#pragma unroll
            for (int m = 0; m < 4; ++m) { bf16_t* rowp = A + (size_t)(row0 + ai * HALF + m * 16) * 2816;
#pragma unroll
                for (int bj = 0; bj < 2; ++bj) { const f32x4 g = acc[ai][bj][m][0], up = acc[ai][bj][m][1]; f32x4 o;
#pragma unroll
                    for (int e = 0; e < 4; ++e) { const float sg = __builtin_amdgcn_rcpf(1.0f + __builtin_amdgcn_exp2f(-1.4426950408889634f * g[e])); o[e] = g[e] * sg * up[e]; }
                    u32x2 w; w.x = cvt_pk_bf16(o[0], o[1]); w.y = cvt_pk_bf16(o[2], o[3]);
                    *(u32x2*)(rowp + ((p0 + bj * HALF) >> 1)) = w; } }
    }
};
struct EpiResid {
    static constexpr bool PERM = true, AFTER_DRAIN = false;
    const float* xa; const float* xb; float* out; const float* gate;
    __device__ __forceinline__ void operator()(const f32x4 (&acc)[2][2][4][2], const Unit& u, int wr, int wc, int fr, int fq) const {
        const int row0 = u.pm * BM + wr * 64 + fr; const int col0 = u.pn * BM + wc * 32 + 8 * fq;
        const int rb = u.pm * BM; const int bi = rb < 32768 ? (rb >> 11) : 16 + ((rb - 32768) >> 14);
        f32x4 gv[2][2];
#pragma unroll
        for (int bj = 0; bj < 2; ++bj)
#pragma unroll
            for (int n = 0; n < 2; ++n) gv[bj][n] = *(const f32x4*)(gate + (size_t)bi * 6144 + col0 + bj * HALF + 4 * n) + 1.0f;
#pragma unroll
        for (int ai = 0; ai < 2; ++ai)
#pragma unroll
            for (int m = 0; m < 4; ++m) { const int row = row0 + ai * HALF + m * 16;
                const float* xr = (row < 32768 ? xa + (size_t)row * 1024 : xb + (size_t)(row - 32768) * 1024) + col0; float* orow = out + (size_t)row * 1024 + col0;
#pragma unroll
                for (int bj = 0; bj < 2; ++bj)
#pragma unroll
                    for (int n = 0; n < 2; ++n) { const f32x4 xv = *(const f32x4*)(xr + bj * HALF + 4 * n);
                        *(f32x4*)(orow + bj * HALF + 4 * n) = xv * 1.189207115002721f + gv[bj][n] * acc[ai][bj][m][n]; } }
    }
};
struct EpiResidBf {
    static constexpr bool PERM = true, AFTER_DRAIN = false;
    const float* xa; const float* xb; bf16_t* out; const float* gate;
    __device__ __forceinline__ void operator()(const f32x4 (&acc)[2][2][4][2], const Unit& u, int wr, int wc, int fr, int fq) const {
        const int row0 = u.pm * BM + wr * 64 + fr; const int col0 = u.pn * BM + wc * 32 + 8 * fq;
        const int rb = u.pm * BM; const int bi = rb < 32768 ? (rb >> 11) : 16 + ((rb - 32768) >> 14);
        f32x4 gv[2][2];
#pragma unroll
        for (int bj = 0; bj < 2; ++bj)
#pragma unroll
            for (int n = 0; n < 2; ++n) gv[bj][n] = *(const f32x4*)(gate + (size_t)bi * 6144 + col0 + bj * HALF + 4 * n) + 1.0f;
#pragma unroll
        for (int ai = 0; ai < 2; ++ai)
#pragma unroll
            for (int m = 0; m < 4; ++m) { const int row = row0 + ai * HALF + m * 16;
                const float* xr = (row < 32768 ? xa + (size_t)row * 1024 : xb + (size_t)(row - 32768) * 1024) + col0; bf16_t* orow = out + (size_t)row * 1024 + col0;
#pragma unroll
                for (int bj = 0; bj < 2; ++bj) { const f32x4 x0 = *(const f32x4*)(xr + bj * HALF), x1 = *(const f32x4*)(xr + bj * HALF + 4);
                    const f32x4 v0 = x0 * 1.189207115002721f + gv[bj][0] * acc[ai][bj][m][0], v1 = x1 * 1.189207115002721f + gv[bj][1] * acc[ai][bj][m][1];
                    u32x4 w; w.x = cvt_pk_bf16(v0[0], v0[1]); w.y = cvt_pk_bf16(v0[2], v0[3]); w.z = cvt_pk_bf16(v1[0], v1[1]); w.w = cvt_pk_bf16(v1[2], v1[3]);
                    *(u32x4*)(orow + bj * HALF) = w; } }
    }
};
struct EpiResidLn {
    static constexpr bool PERM = true, AFTER_DRAIN = false;
    const bf16_t* y1; const float* stats; const float* lg; const float* lb; bf16_t* out; const float* gate;
    __device__ __forceinline__ void operator()(const f32x4 (&acc)[2][2][4][2], const Unit& u, int wr, int wc, int fr, int fq) const {
        const int row0 = u.pm * BM + wr * 64 + fr; const int col0 = u.pn * BM + wc * 32 + 8 * fq;
        const int rb = u.pm * BM; const int bi = rb < 32768 ? (rb >> 11) : 16 + ((rb - 32768) >> 14);
        f32x4 gv[2][2], lgv[2][2], lbv[2][2];
#pragma unroll
        for (int bj = 0; bj < 2; ++bj)
#pragma unroll
            for (int n = 0; n < 2; ++n) { gv[bj][n] = *(const f32x4*)(gate + (size_t)bi * 6144 + col0 + bj * HALF + 4 * n) + 1.0f;
                lgv[bj][n] = *(const f32x4*)(lg + col0 + bj * HALF + 4 * n) * 1.189207115002721f; lbv[bj][n] = *(const f32x4*)(lb + col0 + bj * HALF + 4 * n) * 1.189207115002721f; }
#pragma unroll
        for (int ai = 0; ai < 2; ++ai)
#pragma unroll
            for (int m = 0; m < 4; ++m) { const int row = row0 + ai * HALF + m * 16;
                const float mean = stats[2 * row], rstd = stats[2 * row + 1];
                const bf16_t* yr = y1 + (size_t)row * 1024 + col0; bf16_t* orow = out + (size_t)row * 1024 + col0;
#pragma unroll
                for (int bj = 0; bj < 2; ++bj) { f32x4 zv[2];
#pragma unroll
                    for (int n = 0; n < 2; ++n) { const u32x2 yw = *(const u32x2*)(yr + bj * HALF + 4 * n);
                        const f32x4 yv = {__builtin_bit_cast(float, yw.x << 16), __builtin_bit_cast(float, yw.x & 0xffff0000u), __builtin_bit_cast(float, yw.y << 16), __builtin_bit_cast(float, yw.y & 0xffff0000u)};
                        zv[n] = (yv - mean) * rstd * lgv[bj][n] + lbv[bj][n] + gv[bj][n] * acc[ai][bj][m][n]; }
                    u32x4 w; w.x = cvt_pk_bf16(zv[0][0], zv[0][1]); w.y = cvt_pk_bf16(zv[0][2], zv[0][3]); w.z = cvt_pk_bf16(zv[1][0], zv[1][1]); w.w = cvt_pk_bf16(zv[1][2], zv[1][3]);
                    *(u32x4*)(orow + bj * HALF) = w; } }
    }
};
template <class Epi, class Sched, bool ALIGN_EPI = false, bool SP2 = false>
__device__ __forceinline__ void gemm_phase(PG8_LAS unsigned char* lds, const Gemm g, const Sched& S, const Epi& E) {
    const int tid = opaque_tid(), wid = __builtin_amdgcn_readfirstlane(tid >> 6), lane = tid & 63, wr = wid >> 2, wc = wid & 3, fr = lane & 15, fq = lane >> 4;
    const int K = g.K, nt = K / BK, LD = g.ld ? g.ld : g.K; const size_t kwb = g.kwin ? (size_t)g.K * 2 : 0;
    unsigned voffA[2], voffB[2];
#pragma unroll
    for (int i = 0; i < 2; ++i) { int R, C; stage_rc(tid * 16 + i * 8192, R, C); const int Rb = Epi::PERM ? ((R & ~31) + perm32(R & 31)) : R;
        voffA[i] = (unsigned)(R * LD + C) * 2u; voffB[i] = (unsigned)(Rb * LD + C) * 2u; }
    const size_t kstep = (size_t)(BK * 2);
    const size_t hstep = (size_t)HALF * LD * 2;
    const size_t tstep = 2 * hstep;
    const unsigned ldsw = (unsigned)wid * 1024u;
    const int aoff = lds_byte(wr * 64 + fr, fq * 8), boff = lds_byte(wc * 32 + fr, fq * 8);
#define PG8_SA(b, h) (((b) * 2 + (h)) * HTB)
#define PG8_SB(b, h) ((4 + (b) * 2 + (h)) * HTB)
#define PG8_STAGE(bufoff, gbase, voff) do { _Pragma("unroll") for (int _i = 0; _i < 2; ++_i) \
        __builtin_amdgcn_global_load_lds((const unsigned*)((const char*)(gbase) + (voff)[_i]), (PG8_LAS unsigned*)(lds + (bufoff) + ldsw + _i * 8192), 16, 0, 0); } while (0)
#define PG8_LDA(dst, b, h) do { _Pragma("unroll") for (int m = 0; m < 4; ++m) _Pragma("unroll") for (int k = 0; k < 2; ++k) dst[m][k] = *(const PG8_LAS bf16x8*)(lds + PG8_SA(b, h) + aoff + m * 2048 + k * 1024); } while (0)
#define PG8_LDB(dst, b, h) do { _Pragma("unroll") for (int n = 0; n < 2; ++n) _Pragma("unroll") for (int k = 0; k < 2; ++k) dst[n][k] = *(const PG8_LAS bf16x8*)(lds + PG8_SB(b, h) + boff + n * 2048 + k * 1024); } while (0)
#define PG8_MMA(ai, bj, At, Bt) do { __builtin_amdgcn_s_setprio(1); _Pragma("unroll") for (int m = 0; m < 4; ++m) _Pragma("unroll") for (int n = 0; n < 2; ++n) _Pragma("unroll") for (int k = 0; k < 2; ++k) \
        acc[ai][bj][m][n] = __builtin_amdgcn_mfma_f32_16x16x32_bf16(Bt[n][k], At[m][k], acc[ai][bj][m][n], 0, 0, 0); __builtin_amdgcn_s_setprio(0); } while (0)
#define PG8_WAIT_V(n) asm volatile("s_waitcnt vmcnt(" #n ")" ::: "memory")
#define PG8_WAIT_L(n) asm volatile("s_waitcnt lgkmcnt(" #n ")" ::: "memory")
#define PG8_BAR __builtin_amdgcn_s_barrier()
#define PG8_SCHED __builtin_amdgcn_sched_barrier(0)
    Unit cur, nxt; int ui = 0;
    if (!S.next(0, cur)) return;
    f32x4 acc[2][2][4][2];
#pragma unroll
    for (int a = 0; a < 2; ++a)
#pragma unroll
        for (int b = 0; b < 2; ++b)
#pragma unroll
            for (int m = 0; m < 4; ++m)
#pragma unroll
                for (int n = 0; n < 2; ++n) acc[a][b][m][n] = (f32x4){0.f, 0.f, 0.f, 0.f};
    bf16x8 At[4][2], B0[2][2], B1[2][2];
    const char* cA = (const char*)g.A + (size_t)cur.pm * tstep + (size_t)cur.pn * kwb; const char* cB = (const char*)g.Bt + (size_t)cur.pn * tstep + (size_t)cur.pn * kwb;
    S.a_ready(cur);
    if constexpr (SP2) {
        PG8_STAGE(PG8_SB(0, 0), cB, voffB); PG8_STAGE(PG8_SB(0, 1), cB + hstep, voffB); PG8_STAGE(PG8_SA(0, 0), cA, voffA); PG8_STAGE(PG8_SA(0, 1), cA + hstep, voffA);
        if (wr == 1) PG8_BAR;
        PG8_WAIT_V(2); PG8_BAR;
        PG8_STAGE(PG8_SB(1, 0), cB + kstep, voffB); PG8_STAGE(PG8_SA(1, 0), cA + kstep, voffA); PG8_STAGE(PG8_SB(1, 1), cB + hstep + kstep, voffB);
        PG8_WAIT_V(6); PG8_BAR;
    } else {
        PG8_STAGE(PG8_SB(0, 0), cB, voffB); PG8_STAGE(PG8_SA(0, 0), cA, voffA); PG8_STAGE(PG8_SB(0, 1), cB + hstep, voffB); PG8_STAGE(PG8_SA(0, 1), cA + hstep, voffA);
        if (wr == 1) PG8_BAR;
        PG8_WAIT_V(4); PG8_BAR;
        PG8_STAGE(PG8_SB(1, 0), cB + kstep, voffB); PG8_STAGE(PG8_SA(1, 0), cA + kstep, voffA); PG8_STAGE(PG8_SB(1, 1), cB + hstep + kstep, voffB);
        PG8_WAIT_V(6); PG8_BAR;
    }
    for (;;) {
        const bool has_next = S.next(ui + 1, nxt);
        const char* nA = has_next ? (const char*)g.A + (size_t)nxt.pm * tstep + (size_t)nxt.pn * kwb : cA; const char* nB = has_next ? (const char*)g.Bt + (size_t)nxt.pn * tstep + (size_t)nxt.pn * kwb : cB;
        for (int t = 0; t < nt; t += 2) {
            const bool last = (t == nt - 2);
            const char* a1 = cA + (size_t)(t + 1) * kstep;
            const char* a2 = last ? nA : cA + (size_t)(t + 2) * kstep; const char* b2 = last ? nB : cB + (size_t)(t + 2) * kstep;
            const char* a3 = a2 + kstep; const char* b3 = b2 + kstep;
            if (last && has_next) S.a_ready(nxt);
            if constexpr (SP2) {
            PG8_LDB(B0, 0, 0); PG8_LDB(B1, 0, 1); PG8_SCHED; PG8_LDA(At, 0, 0); PG8_STAGE(PG8_SA(1, 1), a1 + hstep, voffA);
            PG8_WAIT_V(8); PG8_WAIT_L(0); PG8_BAR; PG8_MMA(0, 0, At, B0); PG8_MMA(0, 1, At, B1); PG8_BAR; PG8_SCHED;
            PG8_LDA(At, 0, 1); PG8_STAGE(PG8_SB(0, 0), b2, voffB); PG8_STAGE(PG8_SB(0, 1), b2 + hstep, voffB); PG8_STAGE(PG8_SA(0, 0), a2, voffA);
            PG8_WAIT_V(8); PG8_WAIT_L(0); PG8_BAR; PG8_MMA(1, 0, At, B0); PG8_MMA(1, 1, At, B1); PG8_BAR; PG8_SCHED;
            PG8_LDB(B0, 1, 0); PG8_LDB(B1, 1, 1); PG8_SCHED; PG8_LDA(At, 1, 0); PG8_STAGE(PG8_SA(0, 1), a2 + hstep, voffA);
            PG8_WAIT_V(8); PG8_WAIT_L(0); PG8_BAR; PG8_MMA(0, 0, At, B0); PG8_MMA(0, 1, At, B1); PG8_BAR; PG8_SCHED;
            PG8_LDA(At, 1, 1); PG8_STAGE(PG8_SB(1, 0), b3, voffB); PG8_STAGE(PG8_SB(1, 1), b3 + hstep, voffB); PG8_STAGE(PG8_SA(1, 0), a3, voffA);
            PG8_WAIT_V(8); PG8_WAIT_L(0); PG8_BAR; PG8_MMA(1, 0, At, B0); PG8_MMA(1, 1, At, B1); PG8_BAR; PG8_SCHED;
            } else {
            PG8_LDB(B0, 0, 0); PG8_SCHED; PG8_LDA(At, 0, 0); PG8_STAGE(PG8_SA(1, 1), a1 + hstep, voffA);
            PG8_WAIT_L(8); PG8_BAR; PG8_WAIT_L(0); PG8_MMA(0, 0, At, B0); PG8_BAR; PG8_SCHED;
            PG8_LDB(B1, 0, 1); PG8_STAGE(PG8_SB(0, 0), b2, voffB);
            PG8_BAR; PG8_WAIT_L(0); PG8_MMA(0, 1, At, B1); PG8_BAR;
            PG8_LDA(At, 0, 1); PG8_STAGE(PG8_SA(0, 0), a2, voffA);
            PG8_BAR; PG8_WAIT_L(0); PG8_MMA(1, 0, At, B0); PG8_BAR; PG8_SCHED;
            PG8_STAGE(PG8_SB(0, 1), b2 + hstep, voffB);
            PG8_WAIT_V(6); PG8_BAR; PG8_MMA(1, 1, At, B1); PG8_BAR;
            PG8_LDB(B0, 1, 0); PG8_SCHED; PG8_LDA(At, 1, 0); PG8_STAGE(PG8_SA(0, 1), a2 + hstep, voffA);
            PG8_WAIT_L(8); PG8_BAR; PG8_WAIT_L(0); PG8_MMA(0, 0, At, B0); PG8_BAR; PG8_SCHED;
            PG8_LDB(B1, 1, 1); PG8_STAGE(PG8_SB(1, 0), b3, voffB);
            PG8_BAR; PG8_WAIT_L(0); PG8_MMA(0, 1, At, B1); PG8_BAR;
            PG8_LDA(At, 1, 1); PG8_STAGE(PG8_SA(1, 0), a3, voffA);
            PG8_BAR; PG8_WAIT_L(0); PG8_MMA(1, 0, At, B0); PG8_BAR; PG8_SCHED;
            PG8_STAGE(PG8_SB(1, 1), b3 + hstep, voffB);
            PG8_WAIT_V(6); PG8_BAR; PG8_MMA(1, 1, At, B1); PG8_BAR;
            }
        }
        if constexpr (ALIGN_EPI) { if (wr == 0) PG8_BAR; }
        if constexpr (!Epi::AFTER_DRAIN) { E(acc, cur, wr, wc, fr, fq); S.done(cur); }
        if (!has_next) break;
#pragma unroll
        for (int a = 0; a < 2; ++a)
#pragma unroll
            for (int b = 0; b < 2; ++b)
#pragma unroll
                for (int m = 0; m < 4; ++m)
#pragma unroll
                    for (int n = 0; n < 2; ++n) acc[a][b][m][n] = (f32x4){0.f, 0.f, 0.f, 0.f};
        cur = nxt; cA = nA; cB = nB; ++ui;
        if constexpr (ALIGN_EPI) { if (wr == 1) PG8_BAR; }
    }
    PG8_WAIT_V(0);
    if constexpr (!ALIGN_EPI) { if (wr == 0) PG8_BAR; }
    PG8_BAR;
    if constexpr (Epi::AFTER_DRAIN) { E.fused(acc, cur, wr, wc, fr, fq, lds, wid, lane); S.done(cur); }
#undef PG8_SA
#undef PG8_SB
#undef PG8_STAGE
#undef PG8_LDA
#undef PG8_LDB
#undef PG8_MMA
#undef PG8_WAIT_V
#undef PG8_WAIT_L
#undef PG8_BAR
#undef PG8_SCHED
}
}
namespace att {
using bf16x8 = __attribute__((ext_vector_type(8))) short;
using s16x4  = __attribute__((ext_vector_type(4))) short;
using f32x16 = __attribute__((ext_vector_type(16))) float;
using u32x4  = __attribute__((ext_vector_type(4))) unsigned;
constexpr int KVBLK = 64, LDK = 512;
constexpr float SCALE = 0.125f;
constexpr float THR = 8.f;
constexpr int SHM_V = 16384, SHM_K = 16384;
#define KSWZ(row, colB) ((row) * 256 + ((colB) ^ (((row) & 15) << 4)))
#define SBAR() __builtin_amdgcn_sched_barrier(0)
__device__ __forceinline__ int crow(int r, int hi) { return (r & 3) + 8 * (r >> 2) + 4 * hi; }
__device__ __forceinline__ unsigned cvtpk(float lo, float hi) { unsigned r; asm volatile("v_cvt_pk_bf16_f32 %0, %1, %2" : "=v"(r) : "v"(lo), "v"(hi)); return r; }

__device__ __forceinline__ void partialSM(f32x16& p0, f32x16& p1, float& m_reg, float& mn, float& alpha) {
  constexpr float C = SCALE * 1.4426950408889634f;
  float pmax = p0[0];
#pragma unroll
  for (int r = 1; r < 16; ++r) pmax = fmaxf(pmax, p0[r]);
#pragma unroll
  for (int r = 0; r < 16; ++r) pmax = fmaxf(pmax, p1[r]);
  { auto rr = __builtin_amdgcn_permlane32_swap(__float_as_uint(pmax), __float_as_uint(pmax), false, false);
    pmax = fmaxf(__uint_as_float(rr[0]), __uint_as_float(rr[1])); }
  if (__builtin_expect(__all(pmax - m_reg <= THR / SCALE), 1)) { mn = m_reg; alpha = 1.f; }
  else { mn = fmaxf(m_reg, pmax); alpha = __builtin_amdgcn_exp2f((m_reg - mn) * C); m_reg = mn; }
  float mnC = -mn * C;
#pragma unroll
  for (int r = 0; r < 16; ++r) p0[r] = fmaf(p0[r], C, mnC);
#pragma unroll
  for (int r = 0; r < 16; ++r) p1[r] = fmaf(p1[r], C, mnC);
#pragma unroll
  for (int r = 0; r < 16; ++r) p0[r] = __builtin_amdgcn_exp2f(p0[r]);
}
__device__ __forceinline__ void finishSM(f32x16& p0, f32x16& p1, float alpha, float& l_reg, bf16x8& pa0, bf16x8& pa1, bf16x8& pa2, bf16x8& pa3) {
#pragma unroll
  for (int r = 0; r < 16; ++r) p1[r] = __builtin_amdgcn_exp2f(p1[r]);
  float ps = 0;
#pragma unroll
  for (int r = 0; r < 16; ++r) ps += p0[r];
#pragma unroll
  for (int r = 0; r < 16; ++r) ps += p1[r];
  { auto rr = __builtin_amdgcn_permlane32_swap(__float_as_uint(ps), __float_as_uint(ps), false, false);
    ps = __uint_as_float(rr[0]) + __uint_as_float(rr[1]); }
  l_reg = l_reg * alpha + ps;
#define PK4(P, BASE, OUT) do { unsigned a0 = cvtpk(P[BASE + 0], P[BASE + 1]), a1 = cvtpk(P[BASE + 2], P[BASE + 3]);   \
    unsigned b0 = cvtpk(P[BASE + 4], P[BASE + 5]), b1 = cvtpk(P[BASE + 6], P[BASE + 7]);                              \
    auto r0 = __builtin_amdgcn_permlane32_swap(a0, b0, false, false); auto r1 = __builtin_amdgcn_permlane32_swap(a1, b1, false, false); \
    u32x4 w = {r0[0], r1[0], r0[1], r1[1]}; OUT = *reinterpret_cast<bf16x8*>(&w); } while (0)
  PK4(p0, 0, pa0); PK4(p0, 8, pa1); PK4(p1, 0, pa2); PK4(p1, 8, pa3);
#undef PK4
}
__device__ __forceinline__ void qkt(f32x16& p0, f32x16& p1, const char* Ks, const bf16x8* qr, int r32, int hi, int cmap) {
  p0 = f32x16{}; p1 = f32x16{};
#pragma unroll
  for (int d0 = 0; d0 < 4; ++d0) { int cb = (cmap * 64 + d0 * 16 + hi * 8) * 2;
    bf16x8 b0 = *reinterpret_cast<const bf16x8*>(Ks + KSWZ(r32, cb));
    bf16x8 b1 = *reinterpret_cast<const bf16x8*>(Ks + KSWZ(32 + r32, cb));
    p0 = __builtin_amdgcn_mfma_f32_32x32x16_bf16(b0, qr[d0], p0, 0, 0, 0);
    p1 = __builtin_amdgcn_mfma_f32_32x32x16_bf16(b1, qr[d0], p1, 0, 0, 0); }
}
__device__ __forceinline__ void qkt_load(bf16x8 (&kf)[8], const char* Ks, int r32, int hi, int cmap) {
#pragma unroll
  for (int d0 = 0; d0 < 4; ++d0) { int cb = (cmap * 64 + d0 * 16 + hi * 8) * 2;
    kf[2 * d0] = *reinterpret_cast<const bf16x8*>(Ks + KSWZ(r32, cb)); kf[2 * d0 + 1] = *reinterpret_cast<const bf16x8*>(Ks + KSWZ(32 + r32, cb)); }
}
__device__ __forceinline__ void qkt_mma(f32x16& p0, f32x16& p1, const bf16x8 (&kf)[8], const bf16x8* qr) {
  p0 = f32x16{}; p1 = f32x16{};
#pragma unroll
  for (int d0 = 0; d0 < 4; ++d0) { p0 = __builtin_amdgcn_mfma_f32_32x32x16_bf16(kf[2 * d0], qr[d0], p0, 0, 0, 0); p1 = __builtin_amdgcn_mfma_f32_32x32x16_bf16(kf[2 * d0 + 1], qr[d0], p1, 0, 0, 0); }
}
__device__ __forceinline__ int v_st(int k, int c) { const int kk = (k & ~0xC) | ((k & 4) << 1) | ((k & 8) >> 1); return ((kk >> 3) * 4 + (c >> 5)) * 512 + ((kk & 7) * 32 + (c & 31)) * 2; }
__device__ __forceinline__ int v_rd_base(int lane) { return ((lane & 3) << 3) | (((lane >> 2) & 3) << 6) | (((lane >> 4) & 1) << 5) | (((lane >> 5) & 1) << 8); }
constexpr int v_rd_off(int d0, int ks, int half) { return d0 * 512 + ks * 4096 + half * 2048; }
template <int OFF> __device__ __forceinline__ s16x4 tr_read(int vb) {
  s16x4 r; asm volatile("ds_read_b64_tr_b16 %0, %1 offset:%2" : "=&v"(r) : "v"(vb), "i"(OFF) : "memory"); return r;
}
struct VF { s16x4 l0, h0, l1, h1, l2, h2, l3, h3; };
template <int D0> __device__ __forceinline__ void vf_issue(VF& f, int vb) {
  f.l0 = tr_read<v_rd_off(D0, 0, 0)>(vb); f.h0 = tr_read<v_rd_off(D0, 0, 1)>(vb); f.l1 = tr_read<v_rd_off(D0, 1, 0)>(vb); f.h1 = tr_read<v_rd_off(D0, 1, 1)>(vb);
  f.l2 = tr_read<v_rd_off(D0, 2, 0)>(vb); f.h2 = tr_read<v_rd_off(D0, 2, 1)>(vb); f.l3 = tr_read<v_rd_off(D0, 3, 0)>(vb); f.h3 = tr_read<v_rd_off(D0, 3, 1)>(vb);
}
#define PKF(L, H) (bf16x8){L[0], L[1], L[2], L[3], H[0], H[1], H[2], H[3]}
#define MMA4(od, f) do { od = __builtin_amdgcn_mfma_f32_32x32x16_bf16(pa0, PKF(f.l0, f.h0), od, 0, 0, 0); od = __builtin_amdgcn_mfma_f32_32x32x16_bf16(pa1, PKF(f.l1, f.h1), od, 0, 0, 0); \
    od = __builtin_amdgcn_mfma_f32_32x32x16_bf16(pa2, PKF(f.l2, f.h2), od, 0, 0, 0); od = __builtin_amdgcn_mfma_f32_32x32x16_bf16(pa3, PKF(f.l3, f.h3), od, 0, 0, 0); } while (0)
#define PIN(x) asm volatile("" : "+v"(x))
#define WAIT_LGKM(n) asm volatile("s_waitcnt lgkmcnt(" #n ")" ::: "memory")
__device__ __forceinline__ float sm_rowmax(const f32x16& p0, const f32x16& p1) {
  float pmax = p0[0];
#pragma unroll
  for (int r = 1; r < 16; ++r) pmax = fmaxf(pmax, p0[r]);
#pragma unroll
  for (int r = 0; r < 16; ++r) pmax = fmaxf(pmax, p1[r]);
  auto rr = __builtin_amdgcn_permlane32_swap(__float_as_uint(pmax), __float_as_uint(pmax), false, false);
  return fmaxf(__uint_as_float(rr[0]), __uint_as_float(rr[1]));
}
__device__ __forceinline__ void sm_scale(f32x16& p0, f32x16& p1, float pmax, float& m_reg, float& alpha, bool& zero) {
  constexpr float THR2 = THR * 1.4426950408889634f;
  alpha = 1.f;
  if (__builtin_expect(!__all(pmax - m_reg <= THR2), 0)) { const float mn = fmaxf(m_reg, pmax); alpha = __builtin_amdgcn_exp2f(m_reg - mn); m_reg = mn; zero = false; }
  if (__builtin_expect(!zero, 0)) {
#pragma unroll
    for (int r = 0; r < 16; ++r) { p0[r] -= m_reg; p1[r] -= m_reg; }
  }
}
__device__ __forceinline__ void sm_exp(f32x16& p) {
#pragma unroll
  for (int r = 0; r < 16; ++r) p[r] = __builtin_amdgcn_exp2f(p[r]);
}
__device__ __forceinline__ void sm_finish(const f32x16& p0, const f32x16& p1, float alpha, float& l_reg, bf16x8& pa0, bf16x8& pa1, bf16x8& pa2, bf16x8& pa3) {
  float ps = 0;
#pragma unroll
  for (int r = 0; r < 16; ++r) ps += p0[r];
#pragma unroll
  for (int r = 0; r < 16; ++r) ps += p1[r];
  { auto rr = __builtin_amdgcn_permlane32_swap(__float_as_uint(ps), __float_as_uint(ps), false, false);
    ps = __uint_as_float(rr[0]) + __uint_as_float(rr[1]); }
  l_reg = l_reg * alpha + ps;
#define PK8(P, BASE, OUT) do { u32x4 w = {cvtpk(P[BASE + 0], P[BASE + 1]), cvtpk(P[BASE + 2], P[BASE + 3]), cvtpk(P[BASE + 4], P[BASE + 5]), cvtpk(P[BASE + 6], P[BASE + 7])}; \
    OUT = *reinterpret_cast<bf16x8*>(&w); } while (0)
  PK8(p0, 0, pa0); PK8(p0, 8, pa1); PK8(p1, 0, pa2); PK8(p1, 8, pa3);
#undef PK8
}
__device__ __forceinline__ unsigned short f2bf(float f) { unsigned u = __builtin_bit_cast(unsigned, f); return (unsigned short)((u + 0x7fffu + ((u >> 16) & 1u)) >> 16); }

__device__ __forceinline__ float sm_rowsum(const f32x16& p0, const f32x16& p1) {
  float ps = 0;
#pragma unroll
  for (int r = 0; r < 16; ++r) ps += p0[r];
#pragma unroll
  for (int r = 0; r < 16; ++r) ps += p1[r];
  auto rr = __builtin_amdgcn_permlane32_swap(__float_as_uint(ps), __float_as_uint(ps), false, false);
  return __uint_as_float(rr[0]) + __uint_as_float(rr[1]);
}
__device__ __forceinline__ void sm_pack(const f32x16& p0, const f32x16& p1, bf16x8& pa0, bf16x8& pa1, bf16x8& pa2, bf16x8& pa3) {
#define PK8(P, BASE, OUT) do { u32x4 w = {cvtpk(P[BASE + 0], P[BASE + 1]), cvtpk(P[BASE + 2], P[BASE + 3]), cvtpk(P[BASE + 4], P[BASE + 5]), cvtpk(P[BASE + 6], P[BASE + 7])}; \
    OUT = *reinterpret_cast<bf16x8*>(&w); } while (0)
  PK8(p0, 0, pa0); PK8(p0, 8, pa1); PK8(p1, 0, pa2); PK8(p1, 8, pa3);
#undef PK8
}
template <int LO, int HI> __device__ __forceinline__ void sm_exp_rng(f32x16& p0, f32x16& p1) {
#pragma unroll
  for (int i = LO; i < HI; ++i) { if (i < 16) p0[i] = __builtin_amdgcn_exp2f(p0[i]); else p1[i - 16] = __builtin_amdgcn_exp2f(p1[i - 16]); }
}
__device__ __forceinline__ void glds16(const void* gsrc, unsigned lds_dst) { unsigned keep;
  asm volatile("s_mov_b32 %0, m0\n\ts_mov_b32 m0, %2\n\ts_nop 0\n\tglobal_load_lds_dwordx4 %1, off\n\ts_mov_b32 m0, %0" : "=&s"(keep) : "v"(gsrc), "s"(lds_dst) : "memory"); }
#define WAIT_BAR(N) asm volatile("s_waitcnt vmcnt(" #N ") lgkmcnt(0)\n\ts_barrier" ::: "memory")
template <bool FAST>
__device__ __forceinline__ bool attn_unit(const bf16_t* __restrict__ Qb, const bf16_t* __restrict__ Kh, const bf16_t* __restrict__ Vh,
                                          bf16_t* __restrict__ Ob, int seq, char* lds, float lam, const float* __restrict__ subg) {
  const int tid = opaque_tid(), wid = tid >> 6, lane = tid & 63, r32 = lane & 31, hi = lane >> 5;
  const int qg = wid & 3, cmap = wid >> 2;
  constexpr int BUFB = 32768;
  float* ws = (float*)(lds + 4 * BUFB) + wid * 64; float* li_l = ws; float* al_l = ws + 32;
  float m_reg = 0.f, l_reg = 0; bool zero = true; f32x16 o[4] = {}; bf16x8 qr[4];
  const bf16_t* Qw = Qb + (long)(qg * 32 + r32) * LDK + cmap * 64 + hi * 8;
#pragma unroll
  for (int d0 = 0; d0 < 4; ++d0) qr[d0] = *reinterpret_cast<const bf16x8*>(Qw + d0 * 16);
  const unsigned lds0 = (unsigned)(uintptr_t)lds;
  const int vb0 = (int)lds0 + v_rd_base(lane);
  int koff[2], voff[2];
#pragma unroll
  for (int i = 0; i < 2; ++i) { const int c = wid + 8 * i;
    { const int row = 4 * c + (lane >> 4), sch = (lane & 15) ^ (row & 15); koff[i] = row * LDK + sch * 8; }
    { const int st = 2 * c + (lane >> 5), kk = (st >> 2) * 8 + ((lane & 31) >> 2), k = kk, col = (st & 3) * 32 + (lane & 3) * 8; voff[i] = k * LDK + col; } }
  const unsigned dstw = lds0 + (unsigned)wid * 1024u;
#define DMA_TILE(t, boff) do { const bf16_t* kt_ = Kh + (long)(t) * (KVBLK * LDK); const bf16_t* vt_ = Vh + (long)(t) * (KVBLK * LDK); \
    const unsigned d_ = (unsigned)__builtin_amdgcn_readfirstlane((int)(dstw + (unsigned)(boff))); \
    glds16(kt_ + koff[0], d_ + 16384u); glds16(kt_ + koff[1], d_ + 16384u + 8192u); glds16(vt_ + voff[0], d_); glds16(vt_ + voff[1], d_ + 8192u); } while (0)
#define RESC(a) do { if (__any((a) < 1.f)) { if (hi == 0) al_l[r32] = (a); asm volatile("s_waitcnt lgkmcnt(0)" ::: "memory"); \
    _Pragma("unroll") for (int d = 0; d < 4; ++d) _Pragma("unroll") for (int r = 0; r < 16; ++r) o[d][r] *= al_l[crow(r, hi)]; } } while (0)
  f32x16 pA0, pA1, pB0, pB1; float alA, alB; bf16x8 pa0, pa1, pa2, pa3; const int NT = seq / KVBLK;
  int kv_prev = 0, kv_cur = BUFB, kv_n1 = 2 * BUFB, kv_n2 = 3 * BUFB;
  asm volatile("s_waitcnt vmcnt(0)" ::: "memory");
  DMA_TILE(0, 0); DMA_TILE(1, BUFB); DMA_TILE(2, 2 * BUFB);
  WAIT_BAR(8);
  qkt(pA0, pA1, lds + 16384, qr, r32, hi, cmap);
  alA = 1.f; alB = 1.f;
  if constexpr (FAST) { sm_exp(pA0); sm_exp(pA1); }
  else { const float pm = sm_rowmax(pA0, pA1);
    if (!__all(fabsf(pm) <= THR * 1.4426950408889634f)) { m_reg = pm; zero = false; }
    if (!zero) {
#pragma unroll
      for (int r = 0; r < 16; ++r) { pA0[r] -= m_reg; pA1[r] -= m_reg; } }
    sm_exp(pA0); sm_exp(pA1); }
  WAIT_BAR(4);
#define STEP_SLOW(C0, C1, P0, P1, alC, alP, LDCOND, LDT) do { \
    const bool ld_ = (LDCOND); if (ld_) DMA_TILE(LDT, kv_n2); SBAR(); \
    const int vb = vb0 + kv_prev; VF fa, fb; \
    vf_issue<0>(fa, vb); SBAR(); \
    qkt(C0, C1, lds + kv_cur + 16384, qr, r32, hi, cmap); \
    sm_finish(P0, P1, alP, l_reg, pa0, pa1, pa2, pa3); SBAR(); \
    vf_issue<1>(fb, vb); WAIT_LGKM(8); SBAR(); \
    MMA4(o[0], fa); float pm_ = sm_rowmax(C0, C1); PIN(pm_); SBAR(); \
    vf_issue<2>(fa, vb); WAIT_LGKM(8); SBAR(); \
    MMA4(o[1], fb); sm_scale(C0, C1, pm_, m_reg, alC, zero); PIN(C0); PIN(C1); SBAR(); \
    vf_issue<3>(fb, vb); WAIT_LGKM(8); SBAR(); \
    MMA4(o[2], fa); sm_exp(C0); PIN(C0); SBAR(); \
    WAIT_LGKM(0); SBAR(); \
    MMA4(o[3], fb); sm_exp(C1); PIN(C1); SBAR(); \
    RESC(alC); \
    if (ld_) WAIT_BAR(4); else WAIT_BAR(0); \
    { const int t_ = kv_prev; kv_prev = kv_cur; kv_cur = kv_n1; kv_n1 = kv_n2; kv_n2 = t_; } } while (0)
#define STEP_FAST(C0, C1, P0, P1, LDCOND, LDT) do { \
    const bool ld_ = (LDCOND); if (ld_) DMA_TILE(LDT, kv_n2); SBAR(); \
    const int vb = vb0 + kv_prev; VF fa, fb; \
    vf_issue<0>(fa, vb); SBAR(); \
    bf16x8 kf_[8]; qkt_load(kf_, lds + kv_cur + 16384, r32, hi, cmap); SBAR(); \
    l_reg += sm_rowsum(P0, P1); PIN(l_reg); SBAR();                \
    qkt_mma(C0, C1, kf_, qr); sm_pack(P0, P1, pa0, pa1, pa2, pa3); SBAR(); \
    vf_issue<1>(fb, vb); WAIT_LGKM(8); SBAR(); \
    MMA4(o[0], fa); sm_exp_rng<0, 8>(C0, C1); PIN(C0); SBAR(); \
    vf_issue<2>(fa, vb); WAIT_LGKM(8); SBAR(); \
    MMA4(o[1], fb); sm_exp_rng<8, 16>(C0, C1); PIN(C0); SBAR(); \
    vf_issue<3>(fb, vb); WAIT_LGKM(8); SBAR(); \
    MMA4(o[2], fa); sm_exp_rng<16, 24>(C0, C1); PIN(C1); SBAR(); \
    WAIT_LGKM(0); SBAR(); \
    MMA4(o[3], fb); sm_exp_rng<24, 32>(C0, C1); PIN(C1); SBAR(); \
    if (ld_) WAIT_BAR(4); else WAIT_BAR(0); \
    { const int t_ = kv_prev; kv_prev = kv_cur; kv_cur = kv_n1; kv_n1 = kv_n2; kv_n2 = t_; } } while (0)
#define STEP(C0, C1, P0, P1, alC, alP, LDCOND, LDT) do { if constexpr (FAST) STEP_FAST(C0, C1, P0, P1, LDCOND, LDT); else STEP_SLOW(C0, C1, P0, P1, alC, alP, LDCOND, LDT); } while (0)
  for (int j = 1; j + 1 < NT; j += 2) {
    STEP(pB0, pB1, pA0, pA1, alB, alA, (j + 2 < NT), j + 2);
    STEP(pA0, pA1, pB0, pB1, alA, alB, (j + 3 < NT), j + 3);
  }
  STEP(pB0, pB1, pA0, pA1, alB, alA, false, 0);
  {
    const int vb = vb0 + kv_prev; VF fa, fb;
    vf_issue<0>(fa, vb); SBAR();
    if constexpr (FAST) { l_reg += sm_rowsum(pB0, pB1); sm_pack(pB0, pB1, pa0, pa1, pa2, pa3); } else sm_finish(pB0, pB1, alB, l_reg, pa0, pa1, pa2, pa3);
    SBAR();
    vf_issue<1>(fb, vb); WAIT_LGKM(8); SBAR(); MMA4(o[0], fa); SBAR();
    vf_issue<2>(fa, vb); WAIT_LGKM(8); SBAR(); MMA4(o[1], fb); SBAR();
    vf_issue<3>(fb, vb); WAIT_LGKM(8); SBAR(); MMA4(o[2], fa); SBAR();
    WAIT_LGKM(0); SBAR(); MMA4(o[3], fb); SBAR();
  }
#undef STEP
#undef STEP_FAST
#undef STEP_SLOW
#undef DMA_TILE
  if constexpr (FAST) {
    const bool okw = __all(l_reg < 1.8446744e19f && l_reg > 5.4210109e-20f);
    if (lane == 0) li_l[63] = okw ? 1.f : 0.f;
    __syncthreads();
    bool ok = true;
#pragma unroll
    for (int w = 0; w < 8; ++w) ok = ok && (((const float*)(lds + 4 * BUFB))[w * 64 + 63] != 0.f);
    if (!ok) { __syncthreads(); return false; }
  }
  if (hi == 0) li_l[r32] = l_reg; asm volatile("s_waitcnt lgkmcnt(0)" ::: "memory");
  float rli[16];
#pragma unroll
  for (int r = 0; r < 16; ++r) rli[r] = __builtin_amdgcn_rcpf(li_l[crow(r, hi)]);
  __syncthreads();
  float* XB = (float*)lds + qg * (32 * 128);
  if (cmap == 1) {
#pragma unroll
    for (int r = 0; r < 16; ++r)
#pragma unroll
      for (int d0 = 0; d0 < 4; ++d0) XB[crow(r, hi) * 128 + d0 * 32 + r32] = o[d0][r] * rli[r] * (-lam);
  }
  __syncthreads();
  if (cmap == 0) {
    float gsc[4];
#pragma unroll
    for (int d0 = 0; d0 < 4; ++d0) gsc[d0] = subg[d0 * 32 + r32] * (1.0f - 0.2f);
#pragma unroll
    for (int r = 0; r < 16; ++r) { float v[4]; float ss = 0.f;
#pragma unroll
      for (int d0 = 0; d0 < 4; ++d0) { v[d0] = o[d0][r] * rli[r] + XB[crow(r, hi) * 128 + d0 * 32 + r32]; ss += v[d0] * v[d0]; }
      ss += __shfl_xor(ss, 1); ss += __shfl_xor(ss, 2); ss += __shfl_xor(ss, 4); ss += __shfl_xor(ss, 8); ss += __shfl_xor(ss, 16);
      const float rs = 1.0f / sqrtf(ss * (1.0f / 128.0f) + 1e-5f);
      bf16_t* orow = Ob + (long)(qg * 32 + crow(r, hi)) * 1024 + r32;
#pragma unroll
      for (int d0 = 0; d0 < 4; ++d0) orow[d0 * 32] = f2bf(v[d0] * rs * gsc[d0]); }
  }
  __syncthreads();
#undef RESC
  return true;
}
#undef KSWZ
#undef SBAR
}
struct Params { const float* in[21]; float* out; unsigned char* ws; float inv_freq[32]; };
enum { I_XP = 0, I_XS, I_CP, I_CS, I_WADA, I_BADA, I_WIN, I_LQ1, I_LK1, I_LQ2, I_LK2, I_SUBG, I_WF, I_WOUT, I_LN1G, I_LN1B, I_WG, I_WU, I_WD, I_LN2G, I_LN2B };

typedef float f32x4 __attribute__((ext_vector_type(4)));
typedef float f32x16 __attribute__((ext_vector_type(16)));
typedef short bf16x8 __attribute__((ext_vector_type(8)));
typedef short s16x4 __attribute__((ext_vector_type(4)));
typedef unsigned u32x4 __attribute__((ext_vector_type(4)));
typedef unsigned u32x2 __attribute__((ext_vector_type(2)));
#define LDS_WAIT() asm volatile("s_waitcnt lgkmcnt(0)" ::: "memory")

__device__ __forceinline__ unsigned f2bf(float f) { unsigned u = __builtin_bit_cast(unsigned, f); return (u + 0x7fffu + ((u >> 16) & 1u)) >> 16; }
__device__ __forceinline__ unsigned pk2(float lo, float hi) { return f2bf(lo) | (f2bf(hi) << 16); }
__device__ __forceinline__ float bf2f(unsigned short h) { return __builtin_bit_cast(float, (unsigned)h << 16); }
__device__ __forceinline__ float wave_sum(float v) {
#pragma unroll
    for (int o = 1; o < 64; o <<= 1) v += __shfl_xor(v, o);
    return v;
}
__device__ __forceinline__ int batch_of_row(int row) { return row < TOKP ? (row >> 11) : 16 + ((row - TOKP) >> 14); }

template <int MODE> __device__ __forceinline__ const float* src_col(const float* W0, const float* W1, int N0, int p, int& ldn) {
    if (MODE == 0) { ldn = N0; return W0 + p; }
    if (MODE == 1) { ldn = N0; int s = p;
        if (p < 1024) { const int w = p & 511, g64 = w >> 6, r = w & 63, j = r >> 3, e = r & 7; const int d = (e < 4) ? (4 * j + e) : (32 + 4 * j + (e - 4)); s = (p & ~511) + g64 * 64 + d; }
        return W0 + s; }
    { ldn = N0; const int g8 = p >> 3, e = p & 7; return (e < 4) ? (W0 + 4 * g8 + e) : (W1 + 4 * g8 + (e - 4)); }
}
template <int MODE> __device__ __forceinline__ void transpose_item(const float* W0, const float* W1, int K, int N0, int Np, bf16_t* WT, LAS float* scr, int item, int lane) {
    const int nblk = Np / 32, kb = item / nblk, nb = item % nblk, k0 = 64 * kb, n0 = 32 * nb;
    int ldn; const float* src = src_col<MODE>(W0, W1, N0, n0 + (lane & 31), ldn);
#pragma unroll 8
    for (int i = 0; i < 32; ++i) { const int kk = 2 * i + (lane >> 5); scr[kk * 33 + (lane & 31)] = src[(size_t)(k0 + kk) * ldn]; }
    LDS_WAIT(); asm volatile("" ::: "memory");
    const int c = lane & 7;
#pragma unroll
    for (int j = 0; j < 4; ++j) { const int n = (lane >> 3) + 8 * j; const LAS float* s = scr + (8 * c) * 33 + n;
        u32x4 o; o.x = pk2(s[0 * 33], s[1 * 33]); o.y = pk2(s[2 * 33], s[3 * 33]); o.z = pk2(s[4 * 33], s[5 * 33]); o.w = pk2(s[6 * 33], s[7 * 33]);
        *(u32x4*)(WT + (size_t)(n0 + n) * K + k0 + 8 * c) = o; }
    LDS_WAIT(); asm volatile("" ::: "memory");
}
__device__ __forceinline__ void sincos_acc(float ang, float& sn, float& cs) {
    const double x = (double)ang; const double n = __builtin_rint(x * 0.63661977236758134308);
    double r = __builtin_fma(-n, 1.57079632679489655800e+00, x); r = __builtin_fma(-n, 6.12323399573676603587e-17, r);
    const double r2 = r * r;
    const double sp = r2 * (-1.0 / 6 + r2 * (1.0 / 120 + r2 * (-1.0 / 5040 + r2 * (1.0 / 362880 + r2 * (-1.0 / 39916800 + r2 * (1.0 / 6227020800.0 + r2 * (-1.0 / 1307674368000.0)))))));
    const double ss = r + r * sp;
    const double cp = r2 * (-0.5 + r2 * (1.0 / 24 + r2 * (-1.0 / 720 + r2 * (1.0 / 40320 + r2 * (-1.0 / 3628800 + r2 * (1.0 / 479001600.0 + r2 * (-1.0 / 87178291200.0 + r2 * (1.0 / 20922789888000.0))))))));
    const double cc = 1.0 + cp; const int q = ((int)n) & 3;
    const double s_ = (q == 0) ? ss : (q == 1) ? cc : (q == 2) ? -ss : -cc;
    const double c_ = (q == 0) ? cc : (q == 1) ? -ss : (q == 2) ? -cc : ss;
    sn = (float)s_; cs = (float)c_;
}

__device__ __forceinline__ void p0_prologue(const Params& P, unsigned char* lds) {
    const int tid = threadIdx.x, lane = tid & 63, wave = tid >> 6, G = gridDim.x, bid = blockIdx.x;
    unsigned char* ws = P.ws;
    if (bid < 96) {
        float* sl = (float*)lds; float* red = sl + NBATCH * 1024;
        for (int i = tid; i < NBATCH * 1024; i += 512) { const int bi = i >> 10, d = i & 1023; const float c = bi < 16 ? P.in[I_CP][bi * 1024 + d] : P.in[I_CS][(bi - 16) * 1024 + d];
            sl[i] = c / (1.0f + __expf(-c)); }
        __syncthreads();
        for (int unit = bid; unit < 96; unit += G) {
            const int el = tid & 63, ds = tid >> 6, e = unit * 64 + el; float acc[NBATCH];
#pragma unroll
            for (int b = 0; b < NBATCH; ++b) acc[b] = 0.f;
            const float* wa = P.in[I_WADA] + e;
            for (int d = ds * 128; d < ds * 128 + 128; ++d) { const float w = wa[(size_t)d * NMOD];
#pragma unroll
                for (int b = 0; b < NBATCH; ++b) acc[b] += sl[b * 1024 + d] * w; }
#pragma unroll
            for (int b = 0; b < NBATCH; ++b) red[(ds * NBATCH + b) * 64 + el] = acc[b];
            __syncthreads();
            for (int o = tid; o < NBATCH * 64; o += 512) { const int b = o >> 6, e2 = o & 63; float s = P.in[I_BADA][unit * 64 + e2];
#pragma unroll
                for (int d2 = 0; d2 < 8; ++d2) s += red[(d2 * NBATCH + b) * 64 + e2];
                ((float*)(ws + WS_MOD))[b * NMOD + unit * 64 + e2] = s; }
            __syncthreads();
        }
    }
    __syncthreads();
    {
        LAS float* scr = (LAS float*)((LAS unsigned char*)lds + wave * 16384);
        const int gw = bid * 8 + wave, NGW = G * 8;
        constexpr int I_IN = (1024 / 64) * (2048 / 32), I_OUT = (1024 / 64) * (1024 / 32), I_GU = (1024 / 64) * (5632 / 32), I_DN = (2816 / 64) * (1024 / 32);
        for (int it = gw; it < I_IN + I_OUT + I_GU + I_DN; it += NGW) {
            int r = it;
            if (r < I_IN) { transpose_item<1>(P.in[I_WIN], nullptr, 1024, 2048, 2048, (bf16_t*)(ws + WS_WIN), scr, r, lane); continue; } r -= I_IN;
            if (r < I_OUT) { transpose_item<0>(P.in[I_WOUT], nullptr, 1024, 1024, 1024, (bf16_t*)(ws + WS_WOUT), scr, r, lane); continue; } r -= I_OUT;
            if (r < I_GU) { transpose_item<2>(P.in[I_WG], P.in[I_WU], 1024, 2816, 5632, (bf16_t*)(ws + WS_WGU), scr, r, lane); continue; } r -= I_GU;
            transpose_item<0>(P.in[I_WD], nullptr, 2816, 1024, 1024, (bf16_t*)(ws + WS_WDN), scr, r, lane);
        }
    }
    const int gt = bid * 512 + tid, NGT = G * 512;
    for (int i = gt; i < SEQ_S * 32; i += NGT) { const int s = i >> 5, k = i & 31; const float ang = (float)s * P.inv_freq[k]; float sn, cs; sincos_acc(ang, sn, cs);
        float* rp = (float*)(ws + WS_ROPE) + (size_t)s * 64; rp[k] = cs; rp[32 + k] = sn; }
    for (int i = gt; i < 128 * 128; i += NGT) { const int k = i >> 7, n = i & 127; const float fr = (float)((k * n) & 127) * (1.0f / 128.0f);
        const float c = __builtin_amdgcn_cosf(fr), s = __builtin_amdgcn_sinf(fr); bf16_t* t = (bf16_t*)(ws + WS_DFT);
        t[i] = (bf16_t)f2bf(c); t[16384 + i] = (bf16_t)f2bf(s); t[32768 + i] = (bf16_t)f2bf(-s); }
    for (int i = gt; i < 512 * 1024; i += NGT) { const int n = i >> 10, k = i & 1023, g = n >> 7, c = n & 127, g2 = k >> 8, ri = (k >> 7) & 1, c1 = k & 127; float v = 0.f;
        if (g == g2) { const float* wf = P.in[I_WF] + (size_t)g * 16384 + c; float a = 0.f;
            for (int j = 0; j < 128; ++j) { const float fr = (float)((c1 * j) & 127) * (1.0f / 128.0f); const float t = ri ? __builtin_amdgcn_sinf(fr) : __builtin_amdgcn_cosf(fr); a += t * wf[j * 128]; }
            v = a * 0.08838834764831845f; }
        ((bf16_t*)(ws + WS_WFD))[i] = (bf16_t)f2bf(v); }
}

__device__ __forceinline__ void ln_stats(f32x4 (&v)[4], float& mean, float& rstd) {
    float s = 0.f;
#pragma unroll
    for (int j = 0; j < 4; ++j) s += (v[j].x + v[j].y) + (v[j].z + v[j].w);
    mean = wave_sum(s) * (1.f / DM); float s2 = 0.f;
#pragma unroll
    for (int j = 0; j < 4; ++j) { v[j] = v[j] - mean; s2 += (v[j].x * v[j].x + v[j].y * v[j].y) + (v[j].z * v[j].z + v[j].w * v[j].w); }
    rstd = 1.f / sqrtf(wave_sum(s2) * (1.f / DM) + LN_EPS);
}
constexpr int RW = 4;
__device__ __forceinline__ void p1_lnmod(const Params& P) {
    const int lane = threadIdx.x & 63, gw = blockIdx.x * 8 + (threadIdx.x >> 6), NGW = gridDim.x * 8;
    const float* mod = (const float*)(P.ws + WS_MOD); bf16_t* H = (bf16_t*)(P.ws + WS_H1);
    for (int rb = gw * RW; rb < NTOK; rb += NGW * RW) {
        const float* mb = mod + (size_t)batch_of_row(rb) * NMOD;
        f32x4 v[RW][4]; float rstd[RW];
#pragma unroll
        for (int q = 0; q < RW; ++q) { const int row = rb + q; const float* xr = row < TOKP ? P.in[I_XP] + (size_t)row * DM : P.in[I_XS] + (size_t)(row - TOKP) * DM;
#pragma unroll
            for (int j = 0; j < 4; ++j) v[q][j] = ((const f32x4*)xr)[lane + 64 * j]; }
        f32x4 sh[4], sc[4];
#pragma unroll
        for (int j = 0; j < 4; ++j) { sh[j] = ((const f32x4*)mb)[lane + 64 * j]; sc[j] = ((const f32x4*)(mb + 1024))[lane + 64 * j] + 1.0f; }
#pragma unroll
        for (int q = 0; q < RW; ++q) { float mean; ln_stats(v[q], mean, rstd[q]); }
#pragma unroll
        for (int q = 0; q < RW; ++q) { unsigned long long* o8 = (unsigned long long*)(H + (size_t)(rb + q) * DM) + lane;
#pragma unroll
            for (int j = 0; j < 4; ++j) { const f32x4 h = v[q][j] * rstd[q] * sc[j] + sh[j];
                o8[64 * j] = (unsigned long long)pk2(h.x, h.y) | ((unsigned long long)pk2(h.z, h.w) << 32); } }
    }
}
__device__ __forceinline__ void p5_ln1(const Params& P) {
    const int lane = threadIdx.x & 63, gw = blockIdx.x * 8 + (threadIdx.x >> 6), NGW = gridDim.x * 8;
    const float* mod = (const float*)(P.ws + WS_MOD); bf16_t* H = (bf16_t*)(P.ws + WS_MIX); const bf16_t* Y = (const bf16_t*)(P.ws + WS_Y1);
    for (int rb = gw * RW; rb < NTOK; rb += NGW * RW) {
        const float* mb = mod + (size_t)batch_of_row(rb) * NMOD;
        f32x4 v[RW][4]; float rstd[RW];
#pragma unroll
        for (int q = 0; q < RW; ++q) { const bf16_t* yr = Y + (size_t)(rb + q) * DM;
#pragma unroll
            for (int j = 0; j < 4; ++j) { const u32x2 yw = ((const u32x2*)yr)[lane + 64 * j];
                v[q][j] = (f32x4){__builtin_bit_cast(float, yw.x << 16), __builtin_bit_cast(float, yw.x & 0xffff0000u), __builtin_bit_cast(float, yw.y << 16), __builtin_bit_cast(float, yw.y & 0xffff0000u)}; } }
#pragma unroll
        for (int q = 0; q < RW; ++q) { float mean; ln_stats(v[q], mean, rstd[q]); if (lane == 0) { float* st = (float*)(P.ws + WS_STAT) + 2 * (size_t)(rb + q); st[0] = mean; st[1] = rstd[q]; } }
#pragma unroll
        for (int j = 0; j < 4; ++j) { const f32x4 g = ((const f32x4*)P.in[I_LN1G])[lane + 64 * j], b = ((const f32x4*)P.in[I_LN1B])[lane + 64 * j];
#pragma unroll
            for (int q = 0; q < RW; ++q) v[q][j] = v[q][j] * rstd[q] * g + b; }
#pragma unroll
        for (int q = 0; q < RW; ++q) { float mean; ln_stats(v[q], mean, rstd[q]); }
#pragma unroll
        for (int j = 0; j < 4; ++j) { const f32x4 sh = ((const f32x4*)(mb + 3072))[lane + 64 * j], sc = ((const f32x4*)(mb + 4096))[lane + 64 * j] + 1.0f;
#pragma unroll
            for (int q = 0; q < RW; ++q) { const f32x4 h = v[q][j] * rstd[q] * sc + sh;
                ((unsigned long long*)(H + (size_t)(rb + q) * DM))[lane + 64 * j] = (unsigned long long)pk2(h.x, h.y) | ((unsigned long long)pk2(h.z, h.w) << 32); } }
    }
}
__device__ __forceinline__ void p8_ln2(const Params& P) {
    const int lane = threadIdx.x & 63, gw = blockIdx.x * 8 + (threadIdx.x >> 6), NGW = gridDim.x * 8;
    for (int rb = gw * RW; rb < NTOK; rb += NGW * RW) {
        f32x4 v[RW][4]; float rstd[RW];
#pragma unroll
        for (int q = 0; q < RW; ++q) { const bf16_t* zr = (const bf16_t*)(P.ws + WS_X) + (size_t)(rb + q) * DM;
#pragma unroll
            for (int j = 0; j < 4; ++j) { const u32x2 zw = ((const u32x2*)zr)[lane + 64 * j];
                v[q][j] = (f32x4){__builtin_bit_cast(float, zw.x << 16), __builtin_bit_cast(float, zw.x & 0xffff0000u), __builtin_bit_cast(float, zw.y << 16), __builtin_bit_cast(float, zw.y & 0xffff0000u)}; } }
#pragma unroll
        for (int q = 0; q < RW; ++q) { float mean; ln_stats(v[q], mean, rstd[q]); }
#pragma unroll
        for (int j = 0; j < 4; ++j) { const f32x4 g = ((const f32x4*)P.in[I_LN2G])[lane + 64 * j], b = ((const f32x4*)P.in[I_LN2B])[lane + 64 * j];
#pragma unroll
            for (int q = 0; q < RW; ++q) ((f32x4*)(P.out + (size_t)(rb + q) * DM))[lane + 64 * j] = v[q][j] * rstd[q] * g + b; }
    }
}

constexpr int FPB = 576;
typedef short v4i16_t __attribute__((ext_vector_type(4)));
__device__ __forceinline__ bf16x8 fft_bfrag(const LAS unsigned char* p) {
    const s16x4 lo = __builtin_bit_cast(s16x4, __builtin_amdgcn_ds_read_tr16_b64_v4i16((LAS v4i16_t*)p));
    const s16x4 hi = __builtin_bit_cast(s16x4, __builtin_amdgcn_ds_read_tr16_b64_v4i16((LAS v4i16_t*)(p + 4 * FPB)));
    return (bf16x8){lo[0], lo[1], lo[2], lo[3], hi[0], hi[1], hi[2], hi[3]};
}
__device__ __forceinline__ int crow16(int r, int hi) { return (r & 3) + 8 * (r >> 2) + 4 * hi; }

__device__ __forceinline__ void fa_sample_tile(const Params& P, unsigned char* lds, int tile) {
    const int tid = threadIdx.x, lane = tid & 63, wid = tid >> 6, r32 = lane & 31, hi = lane >> 5;
    const int g = tile & 3, n2p = (tile >> 2) & 63, b = tile >> 8;
    const bf16_t* U = (const bf16_t*)(P.ws + WS_Q) + (size_t)3 * NTOK * 512; bf16_t* YP = (bf16_t*)(P.ws + WS_YP);
    const size_t tok0 = (size_t)TOKP + (size_t)b * SEQ_S;
#pragma unroll
    for (int i = 0; i < 8; ++i) { const int c = tid + 512 * i, n1 = c >> 5, w = c & 31, t2 = w >> 4, c8 = w & 15;
        const u32x4 v = *(const u32x4*)(U + (tok0 + 128 * n1 + 2 * n2p + t2) * 512 + g * 128 + c8 * 8);
        *(u32x4*)(lds + n1 * FPB + (t2 * 128 + c8 * 8) * 2) = v; }
    __syncthreads();
    const int wm = wid & 3, wn = wid >> 2;
    const bf16_t* Wc = (const bf16_t*)(P.ws + WS_DFT); const bf16_t* Wn = Wc + 32768;
    const LAS unsigned char* lb = (const LAS unsigned char*)lds + (8 * hi + ((lane & 15) >> 2)) * FPB + (16 * ((lane >> 4) & 1) + 4 * (lane & 3)) * 2 + wn * 256;
    const int n2 = 2 * n2p + wn;
#pragma unroll 1
    for (int half = 0; half < 2; ++half) {
        f32x16 ar[2] = {}, ai[2] = {};
#pragma unroll 4
        for (int kk = 0; kk < 8; ++kk) {
            const bf16x8 fc = *(const bf16x8*)(Wc + (wm * 32 + r32) * 128 + kk * 16 + 8 * hi), fn = *(const bf16x8*)(Wn + (wm * 32 + r32) * 128 + kk * 16 + 8 * hi);
#pragma unroll
            for (int nb = 0; nb < 2; ++nb) { const bf16x8 bf = fft_bfrag(lb + kk * 16 * FPB + (half * 2 + nb) * 64);
                ar[nb] = __builtin_amdgcn_mfma_f32_32x32x16_bf16(fc, bf, ar[nb], 0, 0, 0); ai[nb] = __builtin_amdgcn_mfma_f32_32x32x16_bf16(fn, bf, ai[nb], 0, 0, 0); }
        }
#pragma unroll
        for (int r = 0; r < 16; ++r) { const int k1 = wm * 32 + crow16(r, hi); const float fr = (float)(k1 * n2) * (1.0f / 16384.0f);
            const float tc = __builtin_amdgcn_cosf(fr) * (1.0f / 128.0f), ts = __builtin_amdgcn_sinf(fr) * (1.0f / 128.0f);
            bf16_t* yrow = YP + (tok0 + (size_t)k1 * 128 + n2) * 1024 + g * 256 + half * 64 + r32;
#pragma unroll
            for (int nb = 0; nb < 2; ++nb) { const float yr = ar[nb][r], yi = ai[nb][r];
                yrow[nb * 32] = (bf16_t)f2bf(yr * tc + yi * ts); yrow[128 + nb * 32] = (bf16_t)f2bf(yi * tc - yr * ts); } }
    }
    __syncthreads();
}
__device__ const float C16T[16] = {1.f, 0.9238795325112867f, 0.7071067811865476f, 0.3826834323650898f, 0.f, -0.3826834323650898f, -0.7071067811865476f, -0.9238795325112867f,
                                   -1.f, -0.9238795325112867f, -0.7071067811865476f, -0.3826834323650898f, 0.f, 0.3826834323650898f, 0.7071067811865476f, 0.9238795325112867f};
__device__ __forceinline__ void fa_prompt(const Params& P) {
    const bf16_t* U = (const bf16_t*)(P.ws + WS_Q) + (size_t)3 * NTOK * 512; bf16_t* YP = (bf16_t*)(P.ws + WS_YP);
    const int NGT = gridDim.x * 512;
    for (int it = blockIdx.x * 512 + threadIdx.x; it < 16 * 128 * 256; it += NGT) {
        const int cp = it & 255, n2 = (it >> 8) & 127, b = it >> 15; float x0[16], x1[16];
#pragma unroll
        for (int n1 = 0; n1 < 16; ++n1) { const unsigned w = *(const unsigned*)(U + ((size_t)b * SEQ_P + 128 * n1 + n2) * 512 + 2 * cp); x0[n1] = __builtin_bit_cast(float, w << 16); x1[n1] = __builtin_bit_cast(float, w & 0xffff0000u); }
        const int col = 2 * cp, g = col >> 7, ch = col & 127;
#pragma unroll
        for (int k1 = 0; k1 < 16; ++k1) { float r0 = 0.f, i0 = 0.f, r1 = 0.f, i1 = 0.f;
#pragma unroll
            for (int n1 = 0; n1 < 16; ++n1) { const float c = C16T[(k1 * n1) & 15], s = C16T[((k1 * n1) + 12) & 15]; r0 += x0[n1] * c; i0 -= x0[n1] * s; r1 += x1[n1] * c; i1 -= x1[n1] * s; }
            const float fr = (float)(k1 * n2) * (1.0f / 2048.0f); const float sc = 0.022097086912079608f;
            const float tc = __builtin_amdgcn_cosf(fr) * sc, ts = __builtin_amdgcn_sinf(fr) * sc;
            bf16_t* yrow = YP + ((size_t)b * SEQ_P + (size_t)k1 * 128 + n2) * 1024 + g * 256 + ch;
            *(unsigned*)yrow = pk2(r0 * tc + i0 * ts, r1 * tc + i1 * ts); *(unsigned*)(yrow + 128) = pk2(i0 * tc - r0 * ts, i1 * tc - r1 * ts); }
    }
}
__device__ __forceinline__ void fc_tile(const Params& P, unsigned char* lds, size_t tokb, int N1, int k1, int g) {
    const int tid = threadIdx.x, lane = tid & 63, wid = tid >> 6, r32 = lane & 31, hi = lane >> 5;
    const bf16_t* YP = (const bf16_t*)(P.ws + WS_YP); bf16_t* X = (bf16_t*)(P.ws + WS_X);
#pragma unroll
    for (int i = 0; i < 8; ++i) { const int c = tid + 512 * i, n2 = c >> 5, w = c & 31;
        const u32x4 v = *(const u32x4*)(YP + (tokb + (size_t)k1 * 128 + n2) * 1024 + g * 256 + w * 8);
        *(u32x4*)(lds + n2 * FPB + w * 16) = v; }
    __syncthreads();
    const int wm = wid & 3, wn = wid >> 2;
    const bf16_t* Wc = (const bf16_t*)(P.ws + WS_DFT); const bf16_t* Ws = Wc + 16384; const bf16_t* Wn = Wc + 32768;
    const LAS unsigned char* lb = (const LAS unsigned char*)lds + (8 * hi + ((lane & 15) >> 2)) * FPB + (16 * ((lane >> 4) & 1) + 4 * (lane & 3)) * 2 + wn * 128;
    f32x16 ar[2] = {}, ai[2] = {};
#pragma unroll 4
    for (int kk = 0; kk < 8; ++kk) { const int ao = (wm * 32 + r32) * 128 + kk * 16 + 8 * hi;
        const bf16x8 fc = *(const bf16x8*)(Wc + ao), fs = *(const bf16x8*)(Ws + ao), fn = *(const bf16x8*)(Wn + ao);
#pragma unroll
        for (int nb = 0; nb < 2; ++nb) { const bf16x8 bre = fft_bfrag(lb + kk * 16 * FPB + nb * 64), bim = fft_bfrag(lb + kk * 16 * FPB + 256 + nb * 64);
            ar[nb] = __builtin_amdgcn_mfma_f32_32x32x16_bf16(fc, bre, ar[nb], 0, 0, 0); ar[nb] = __builtin_amdgcn_mfma_f32_32x32x16_bf16(fs, bim, ar[nb], 0, 0, 0);
            ai[nb] = __builtin_amdgcn_mfma_f32_32x32x16_bf16(fc, bim, ai[nb], 0, 0, 0); ai[nb] = __builtin_amdgcn_mfma_f32_32x32x16_bf16(fn, bre, ai[nb], 0, 0, 0); }
    }
#pragma unroll
    for (int r = 0; r < 16; ++r) { const int k2 = wm * 32 + crow16(r, hi);
        bf16_t* xrow = X + (tokb + (size_t)k1 + (size_t)N1 * k2) * 1024 + g * 256 + wn * 64 + r32;
#pragma unroll
        for (int nb = 0; nb < 2; ++nb) { xrow[nb * 32] = (bf16_t)f2bf(ar[nb][r]); xrow[128 + nb * 32] = (bf16_t)f2bf(ai[nb][r]); } }
    __syncthreads();
}

#define XB_TMO      128
#define XB_XCNT(j)  (256  + 64 * (j))
#define XB_XSUB(j)  (1280 + 64 * (j))
#define XB_XGEN(j)  (2304 + 64 * (j))
#define XB_TOP      3328
#define XB_TOPGEN   3392
#define XCD_BAR_WORDS 3456
#define XB_SPIN_CAP (1u << 18)

__device__ __forceinline__ unsigned xb_ld(unsigned* p)              { return __hip_atomic_load(p, __ATOMIC_RELAXED, __HIP_MEMORY_SCOPE_AGENT); }
__device__ __forceinline__ unsigned xb_add(unsigned* p, unsigned v) { return __hip_atomic_fetch_add(p, v, __ATOMIC_RELAXED, __HIP_MEMORY_SCOPE_AGENT); }
__device__ __forceinline__ unsigned xb_xcc_id() { return (unsigned)__builtin_amdgcn_s_getreg((3 << 11) | 20) & 0xFu; }
#define XB_SPIN(cond, bar) do { unsigned _sp = 0; while (cond) { __builtin_amdgcn_s_sleep(1); \
    if ((++_sp & 255u) == 0u) { if (xb_ld(&(bar)[XB_TMO])) break; if (_sp > XB_SPIN_CAP) { atomicAdd(&(bar)[XB_TMO], 1u); break; } } } } while (0)

struct XcdBarrier {
    unsigned* bar; unsigned x;
    volatile LAS unsigned* st;
};

__device__ __forceinline__ XcdBarrier xcd_barrier_post(unsigned* bar, volatile LAS unsigned* st) {
    XcdBarrier b; b.bar = bar; b.x = xb_xcc_id(); b.st = st;
    if (threadIdx.x == 0) (void)xb_add(&bar[XB_XCNT(b.x)], 1u);
    return b;
}
__device__ __forceinline__ void xcd_barrier_complete(unsigned* bar, unsigned x, unsigned& nloc, unsigned& nx) {
    const unsigned G = gridDim.x * gridDim.y * gridDim.z;
    unsigned sum, cnt, mine, sp = 0u;
    for (;;) {
        sum = 0u; cnt = 0u; mine = 0u;
#pragma unroll
        for (unsigned j = 0; j < 16; ++j) { const unsigned c = xb_ld(&bar[XB_XCNT(j)]); sum += c; cnt += (c > 0u) ? 1u : 0u; mine = (j == x) ? c : mine; }
        if (sum == G) break;
        __builtin_amdgcn_s_sleep(1);
        if ((++sp & 255u) == 0u) { if (xb_ld(&bar[XB_TMO])) break; if (sp > XB_SPIN_CAP) { atomicAdd(&bar[XB_TMO], 1u); break; } }
    }
    nloc = mine > 0u ? mine : 1u; nx = cnt > 0u ? cnt : 1u;
}

__device__ __forceinline__ void xcd_barrier(const XcdBarrier& b) {
    asm volatile("s_waitcnt vmcnt(0)" ::: "memory");
    __syncthreads();
    if (threadIdx.x == 0) {
        unsigned* bar = b.bar;
        __builtin_amdgcn_s_waitcnt(0);
        unsigned nloc = b.st[0], nx = b.st[1];
        if (nloc == 0u) { xcd_barrier_complete(bar, b.x, nloc, nx); b.st[0] = nloc; b.st[1] = nx; }
        const unsigned old = xb_add(&bar[XB_XSUB(b.x)], 1u);
        const unsigned gen = old / nloc;
        if (old + 1u == (gen + 1u) * nloc) {
            __builtin_amdgcn_fence(__ATOMIC_RELEASE, "agent");
            asm volatile("s_waitcnt vmcnt(0)" ::: "memory");
            const unsigned og = xb_add(&bar[XB_TOP], 1u);
            const unsigned tg = og / nx;
            if (og + 1u == (tg + 1u) * nx) xb_add(&bar[XB_TOPGEN], 1u);
            else XB_SPIN(xb_ld(&bar[XB_TOPGEN]) == tg, bar);
            __builtin_amdgcn_fence(__ATOMIC_ACQUIRE, "agent");
            xb_add(&bar[XB_XGEN(b.x)], 1u);
            asm volatile("s_waitcnt vmcnt(0)" ::: "memory");
        } else {
            XB_SPIN(xb_ld(&bar[XB_XGEN(b.x)]) == gen, bar);
            __builtin_amdgcn_fence(__ATOMIC_ACQUIRE, "agent");
            asm volatile("s_waitcnt vmcnt(0)" ::: "memory");
        }
    }
    __syncthreads();
}

__device__ __forceinline__ void grid_bar(unsigned* ctr, unsigned target) {
    asm volatile("s_waitcnt vmcnt(0) lgkmcnt(0)" ::: "memory");
    __syncthreads();
    if (threadIdx.x == 0) {
        __builtin_amdgcn_fence(__ATOMIC_RELEASE, "agent");
        asm volatile("s_waitcnt vmcnt(0)" ::: "memory");
        __hip_atomic_fetch_add(ctr, 1u, __ATOMIC_RELAXED, __HIP_MEMORY_SCOPE_AGENT);
        while (__hip_atomic_load(ctr, __ATOMIC_RELAXED, __HIP_MEMORY_SCOPE_AGENT) < target) __builtin_amdgcn_s_sleep(2);
        __builtin_amdgcn_fence(__ATOMIC_ACQUIRE, "agent");
        asm volatile("s_waitcnt vmcnt(0)" ::: "memory");
    }
    __syncthreads();
}

__global__ void __launch_bounds__(512, 2) fwd_megakernel(Params P) {
    extern __shared__ __attribute__((aligned(16))) unsigned char lds[];
    cg::grid_group grid = cg::this_grid();
    unsigned char* ws = P.ws; const int G = gridDim.x, bid = blockIdx.x;
    bf16_t* Qb = (bf16_t*)(ws + WS_Q); const size_t QS = (size_t)NTOK * 512;
    const float* mod = (const float*)(ws + WS_MOD);
    volatile LAS unsigned* xst = (volatile LAS unsigned*)((LAS unsigned char*)lds + (LDS_BYTES - 64));
    if (threadIdx.x < 2) xst[threadIdx.x] = 0u;
    __syncthreads();
    const XcdBarrier xbar = xcd_barrier_post((unsigned*)(ws + WS_BAR), xst);
#define GBAR() xcd_barrier(xbar)

    p0_prologue(P, lds);
    grid.sync();
    p1_lnmod(P);
    GBAR();
#ifndef NO_PH_P2
    { pg8::Gemm g{(const bf16_t*)(ws + WS_H1), (const bf16_t*)(ws + WS_WIN), NTOK, 2048, 1024}; pg8::StaticOrder S; S.init(NTOK, 2048, G, bid);
      pg8::EpiInProj E{Qb, (const float*)(ws + WS_ROPE)};
      pg8::gemm_phase<pg8::EpiInProj, pg8::StaticOrder, true, true>((LAS unsigned char*)lds, g, S, E); }
#endif
    GBAR();
#ifndef NO_PH_FA
    for (int t = bid; t < 512; t += G) fa_sample_tile(P, lds, t);
    fa_prompt(P);
#endif
    GBAR();
#ifndef NO_PH_FC
    for (int t = bid; t < 2048; t += G) {
        if (t < 1024) { const int g = t & 3, k1 = (t >> 2) & 127, b = t >> 9; fc_tile(P, lds, (size_t)TOKP + (size_t)b * SEQ_S, 128, k1, g); }
        else { const int t2 = t - 1024, g = t2 & 3, k1 = (t2 >> 2) & 15, b = t2 >> 6; fc_tile(P, lds, (size_t)b * SEQ_P, 16, k1, g); }
    }
#endif
    GBAR();
#ifndef NO_PH_FD
    { pg8::Gemm g{(const bf16_t*)(ws + WS_X), (const bf16_t*)(ws + WS_WFD), NTOK, 512, 512, 1024, 1};     pg8::StaticOrder S; S.init(NTOK, 512, G, bid);
      pg8::EpiPlain E{(bf16_t*)(ws + WS_MIX), 1024, 512};
      pg8::gemm_phase<pg8::EpiPlain, pg8::StaticOrder, true, true>((LAS unsigned char*)lds, g, S, E); }
    __syncthreads();
#endif
#ifndef NO_PH_ATT
    {
        float lam;
        { float s1 = 0.f, s2 = 0.f;
          for (int i = 0; i < 64; ++i) { s1 += P.in[I_LQ1][i] * P.in[I_LK1][i]; s2 += P.in[I_LQ2][i] * P.in[I_LK2][i]; }
          lam = expf(s1) - expf(s2) + LAMBDA_INIT; }
        for (int idx = bid; idx < 2048; idx += G) {
            int b, h, qb, seq; size_t tok0;
            if (idx < 1024) { const int bh = idx & 7; qb = idx >> 3; b = bh >> 2; h = bh & 3; seq = SEQ_S; tok0 = (size_t)TOKP + (size_t)b * SEQ_S; }
            else { const int i2 = idx - 1024, x = i2 & 7, y = i2 >> 3; qb = y & 15; const int bh = x + 8 * (y >> 4); b = bh >> 2; h = bh & 3; seq = SEQ_P; tok0 = (size_t)b * SEQ_P; }
            const bf16_t* Qp = Qb + (tok0 + (size_t)qb * 128) * 512 + h * 128; const bf16_t* Kp = Qb + QS + tok0 * 512 + h * 128; const bf16_t* Vp = Qb + 2 * QS + tok0 * 512 + h * 128;
            bf16_t* Op = (bf16_t*)(ws + WS_MIX) + (tok0 + (size_t)qb * 128) * 1024 + h * 128;
            if (!att::attn_unit<true>(Qp, Kp, Vp, Op, seq, (char*)lds, lam, P.in[I_SUBG]))
                (void)att::attn_unit<false>(Qp, Kp, Vp, Op, seq, (char*)lds, lam, P.in[I_SUBG]);
        }
    }
#endif
    GBAR();
#ifndef NO_PH_P4
    { pg8::Gemm g{(const bf16_t*)(ws + WS_MIX), (const bf16_t*)(ws + WS_WOUT), NTOK, 1024, 1024}; pg8::StaticOrder S; S.init(NTOK, 1024, G, bid);
      pg8::EpiResidBf E{P.in[I_XP], P.in[I_XS], (bf16_t*)(ws + WS_Y1), mod + 2048};
      pg8::gemm_phase<pg8::EpiResidBf, pg8::StaticOrder, true, true>((LAS unsigned char*)lds, g, S, E); }
#endif
    GBAR();
#ifndef NO_PH_P5
    p5_ln1(P);
#endif
    GBAR();
#ifndef NO_PH_P6
    { pg8::Gemm g{(const bf16_t*)(ws + WS_MIX), (const bf16_t*)(ws + WS_WGU), NTOK, 5632, 1024}; pg8::StaticOrder S; S.init(NTOK, 5632, G, bid);
      pg8::EpiGateUp E{(bf16_t*)(ws + WS_A)};
      pg8::gemm_phase<pg8::EpiGateUp, pg8::StaticOrder, true, true>((LAS unsigned char*)lds, g, S, E); }
#endif
    GBAR();
#ifndef NO_PH_P7
    { pg8::Gemm g{(const bf16_t*)(ws + WS_A), (const bf16_t*)(ws + WS_WDN), NTOK, 1024, 2816}; pg8::StaticOrder S; S.init(NTOK, 1024, G, bid);
      pg8::EpiResidLn E{(const bf16_t*)(ws + WS_Y1), (const float*)(ws + WS_STAT), P.in[I_LN1G], P.in[I_LN1B], (bf16_t*)(ws + WS_X), mod + 5120};
      pg8::gemm_phase<pg8::EpiResidLn, pg8::StaticOrder, true, true>((LAS unsigned char*)lds, g, S, E); }
#endif
    GBAR();
#ifndef NO_PH_P8
    p8_ln2(P);
#endif
}

extern "C" void kernel_launch(void* const* d_in, const int* in_sizes, int n_in, void* d_out, int out_size, void* d_ws, size_t ws_size, hipStream_t stream) {
    static int grid = 0;
    if (grid == 0) {
        if (n_in != 21 || out_size != NTOK * DM || ws_size < WS_END + 16384) { fprintf(stderr, "kernel_launch: unexpected shapes (n_in %d out %d ws %zu)\n", n_in, out_size, ws_size); grid = -1; return; }
        int dev = 0, cus = 0, per_cu = 0;
        (void)hipGetDevice(&dev); (void)hipDeviceGetAttribute(&cus, hipDeviceAttributeMultiprocessorCount, dev);
        if (hipFuncSetAttribute((const void*)fwd_megakernel, hipFuncAttributeMaxDynamicSharedMemorySize, LDS_BYTES) != hipSuccess) { fprintf(stderr, "kernel_launch: hipFuncSetAttribute failed\n"); grid = -1; return; }
        if (hipOccupancyMaxActiveBlocksPerMultiprocessor(&per_cu, (const void*)fwd_megakernel, 512, LDS_BYTES) != hipSuccess || per_cu < 1) { fprintf(stderr, "kernel_launch: occupancy query gave %d\n", per_cu); per_cu = 1; }
        (void)hipGetLastError();
        grid = cus * 1;
        if (grid <= 0) grid = 256;
    }
    if (grid < 0) return;
    Params p{};
    for (int i = 0; i < 21; ++i) p.in[i] = (const float*)d_in[i];
    p.out = (float*)d_out; p.ws = (unsigned char*)d_ws;
    for (int i = 0; i < 32; ++i) p.inv_freq[i] = (float)pow(10000.0, -(double)i / 32.0);
    (void)hipMemsetAsync((unsigned char*)d_ws + WS_BAR, 0, 16384, stream);
    void* args[] = {&p};
    hipError_t e = hipLaunchCooperativeKernel((const void*)fwd_megakernel, dim3(grid), dim3(512), args, LDS_BYTES, stream);
    if (e != hipSuccess) fprintf(stderr, "kernel_launch: cooperative launch failed: %s (grid %d)\n", hipGetErrorString(e), grid);
}
```

```cpp
#include <hip/hip_runtime.h>
#include <hip/hip_cooperative_groups.h>
#include <cstdio>
#include <cstdint>
#include <cmath>
namespace cg = cooperative_groups;

constexpr int DM = 1024, NTOK = 65536, TOKP = 32768, SEQ_P = 2048, SEQ_S = 16384, NBATCH = 18, DFF = 2816, NMOD = 6 * DM;
constexpr float LN_EPS = 1e-5f;
constexpr float ALPHA_C = 1.189207115002721f;
constexpr float LAMBDA_INIT = 0.2f;
constexpr size_t MiB = 1u << 20;
constexpr size_t WS_WIN = 0, WS_WOUT = 4 * MiB, WS_WGU = 6 * MiB, WS_WDN = 17 * MiB, WS_WFD = 23 * MiB, WS_MOD = 24 * MiB, WS_DFT = 25 * MiB, WS_ROPE = 26 * MiB;
constexpr size_t WS_STAT = 30 * MiB;
constexpr size_t WS_H1 = 32 * MiB, WS_X = 160 * MiB;
constexpr size_t WS_Y1 = 32 * MiB;
constexpr size_t WS_Q = 288 * MiB;
constexpr size_t WS_YP = 544 * MiB;
constexpr size_t WS_A = 288 * MiB;
constexpr size_t WS_MIX = 672 * MiB;
constexpr size_t WS_END = 800 * MiB;
constexpr size_t WS_BAR = 800 * MiB;
constexpr int LDS_BYTES = 147456;

typedef unsigned short bf16_t;
#define LAS __attribute__((address_space(3)))
__device__ __forceinline__ int opaque_tid() { int t = threadIdx.x; asm volatile("" : "+v"(t)); return t; }
namespace pg8 {
#define PG8_LAS __attribute__((address_space(3)))
typedef unsigned short bf16_t;
typedef short bf16x8 __attribute__((ext_vector_type(8)));
typedef float f32x4 __attribute__((ext_vector_type(4)));
typedef unsigned u32x4 __attribute__((ext_vector_type(4)));
constexpr int BM = 256, BK = 64, HALF = 128, HTB = HALF * BK * 2  , STAGE_BYTES = 8 * HTB, NXCD = 8, WGM = 8;

__host__ __device__ __forceinline__ int lds_byte(int r, int c) { const int st = (r >> 4) * 2 + (c >> 5), rr = r & 15, cc = c & 31, ob = rr * 64 + cc * 2; return st * 1024 + (ob ^ (((ob >> 9) & 1) << 5)); }
__host__ __device__ __forceinline__ void stage_rc(int b, int& R, int& C) { const int st = b / 1024, sb = b % 1024, swz = sb ^ (((sb >> 9) & 1) << 5); R = (st >> 1) * 16 + swz / 64; C = (st & 1) * 32 + (swz % 64) / 2; }
__host__ __device__ __forceinline__ int perm32(int rho) { const int n = rho >> 4, i = rho & 15; return 8 * (i >> 2) + 4 * n + (i & 3); }

struct Unit { int pm, pn; };
struct Gemm { const bf16_t* A; const bf16_t* Bt; int M, N, K; int ld = 0; int kwin = 0; };

struct StaticOrder {
    int nM, nN, nwg, G, c;
    __host__ __device__ void init(int M, int N, int G_, int c_) { nM = M / BM; nN = N / BM; nwg = nM * nN; G = G_; c = c_; }
    __host__ __device__ bool next(int i, Unit& u) const {
        const long L = (long)i * G + c; if (L >= nwg) return false;
        int wgid = (int)L; { const int q = nwg / NXCD, r = nwg % NXCD, xcd = wgid % NXCD, off = wgid / NXCD; wgid = (xcd < r ? xcd * (q + 1) : r * (q + 1) + (xcd - r) * q) + off; }
        const int nig = WGM * nN, gid = wgid / nig, fm = gid * WGM, gsz = (nM - fm) < WGM ? (nM - fm) : WGM;
        u.pm = fm + ((wgid % nig) % gsz); u.pn = (wgid % nig) / gsz; return true;
    }
    __device__ __forceinline__ void a_ready(const Unit&) const {}
    __device__ __forceinline__ void done(const Unit&) const {}
};

__device__ __forceinline__ unsigned cvt_pk_bf16(float lo, float hi) { unsigned r; asm volatile("v_cvt_pk_bf16_f32 %0, %1, %2" : "=v"(r) : "v"(lo), "v"(hi)); return r; }
typedef float f32x2 __attribute__((ext_vector_type(2)));
typedef unsigned u32x2 __attribute__((ext_vector_type(2)));
struct EpiPlain {
    static constexpr bool PERM = true, AFTER_DRAIN = false;
    bf16_t* O; int ldc; int coff;
    __device__ __forceinline__ void operator()(const f32x4 (&acc)[2][2][4][2], const Unit& u, int wr, int wc, int fr, int fq) const {
        const int row0 = u.pm * BM + wr * 64 + fr; const int col0 = coff + u.pn * BM + wc * 32 + 8 * fq;
#pragma unroll
        for (int ai = 0; ai < 2; ++ai)
#pragma unroll
            for (int m = 0; m < 4; ++m) { bf16_t* rowp = O + (size_t)(row0 + ai * HALF + m * 16) * ldc + col0;
#pragma unroll
                for (int bj = 0; bj < 2; ++bj) { const f32x4 v0 = acc[ai][bj][m][0], v1 = acc[ai][bj][m][1];
                    u32x4 w; w.x = cvt_pk_bf16(v0[0], v0[1]); w.y = cvt_pk_bf16(v0[2], v0[3]); w.z = cvt_pk_bf16(v1[0], v1[1]); w.w = cvt_pk_bf16(v1[2], v1[3]);
                    *(u32x4*)(rowp + bj * HALF) = w; } }
    }
};
struct EpiInProj {
    static constexpr bool PERM = true, AFTER_DRAIN = false;
    bf16_t* qkvu; const float* rope;
    __device__ __forceinline__ void operator()(const f32x4 (&acc)[2][2][4][2], const Unit& u, int wr, int wc, int fr, int fq) const {
        const int row0 = u.pm * BM + wr * 64 + fr; const int region = u.pn >> 1; const int colt = (u.pn & 1) * BM + wc * 32 + 8 * fq;
        bf16_t* base = qkvu + (size_t)region * ((size_t)65536 * 512);
#pragma unroll
        for (int ai = 0; ai < 2; ++ai)
#pragma unroll
            for (int m = 0; m < 4; ++m) { const int row = row0 + ai * HALF + m * 16; const int s = row < 32768 ? (row & 2047) : (row & 16383);
                bf16_t* rowp = base + (size_t)row * 512;
#pragma unroll
                for (int bj = 0; bj < 2; ++bj) { const int col0 = colt + bj * HALF; const f32x4 v0 = acc[ai][bj][m][0], v1 = acc[ai][bj][m][1];
                    if (region < 2) {
                        const int g64 = col0 >> 6, j = (col0 & 63) >> 3;
                        const f32x4 cs = *(const f32x4*)(rope + (size_t)s * 64 + 4 * j), sn = *(const f32x4*)(rope + (size_t)s * 64 + 32 + 4 * j);
                        const float qs = (region == 0) ? 0.18033688011112042f : 1.0f;
                        const f32x4 o1 = (v0 * cs - v1 * sn) * qs, o2 = (v1 * cs + v0 * sn) * qs;
                        u32x2 w1, w2; w1.x = cvt_pk_bf16(o1[0], o1[1]); w1.y = cvt_pk_bf16(o1[2], o1[3]); w2.x = cvt_pk_bf16(o2[0], o2[1]); w2.y = cvt_pk_bf16(o2[2], o2[3]);
                        *(u32x2*)(rowp + g64 * 64 + 4 * j) = w1; *(u32x2*)(rowp + g64 * 64 + 32 + 4 * j) = w2;
                    } else {
                        u32x4 w; w.x = cvt_pk_bf16(v0[0], v0[1]); w.y = cvt_pk_bf16(v0[2], v0[3]); w.z = cvt_pk_bf16(v1[0], v1[1]); w.w = cvt_pk_bf16(v1[2], v1[3]);
                        *(u32x4*)(rowp + col0) = w; }
                } }
    }
};
struct EpiGateUp {
    static constexpr bool PERM = true, AFTER_DRAIN = false;
    bf16_t* A;
    __device__ __forceinline__ void operator()(const f32x4 (&acc)[2][2][4][2], const Unit& u, int wr, int wc, int fr, int fq) const {
        const int row0 = u.pm * BM + wr * 64 + fr; const int p0 = u.pn * BM + wc * 32 + 8 * fq;
#pragma unroll
        for (int ai = 0; ai < 2; ++ai)
#pragma unroll
            for (int m = 0; m < 4; ++m) { bf16_t* rowp = A + (size_t)(row0 + ai * HALF + m * 16) * 2816;
#pragma unroll
                for (int bj = 0; bj < 2; ++bj) { const f32x4 g = acc[ai][bj][m][0], up = acc[ai][bj][m][1]; f32x4 o;
#pragma unroll
                    for (int e = 0; e < 4; ++e) { const float sg = __builtin_amdgcn_rcpf(1.0f + __builtin_amdgcn_exp2f(-1.4426950408889634f * g[e])); o[e] = g[e] * sg * up[e]; }
                    u32x2 w; w.x = cvt_pk_bf16(o[0], o[1]); w.y = cvt_pk_bf16(o[2], o[3]);
                    *(u32x2*)(rowp + ((p0 + bj * HALF) >> 1)) = w; } }
    }
};
struct EpiResid {
    static constexpr bool PERM = true, AFTER_DRAIN = false;
    const float* xa; const float* xb; float* out; const float* gate;
    __device__ __forceinline__ void operator()(const f32x4 (&acc)[2][2][4][2], const Unit& u, int wr, int wc, int fr, int fq) const {
        const int row0 = u.pm * BM + wr * 64 + fr; const int col0 = u.pn * BM + wc * 32 + 8 * fq;
        const int rb = u.pm * BM; const int bi = rb < 32768 ? (rb >> 11) : 16 + ((rb - 32768) >> 14);
        f32x4 gv[2][2];
#pragma unroll
        for (int bj = 0; bj < 2; ++bj)
#pragma unroll
            for (int n = 0; n < 2; ++n) gv[bj][n] = *(const f32x4*)(gate + (size_t)bi * 6144 + col0 + bj * HALF + 4 * n) + 1.0f;
#pragma unroll
        for (int ai = 0; ai < 2; ++ai)
#pragma unroll
            for (int m = 0; m < 4; ++m) { const int row = row0 + ai * HALF + m * 16;
                const float* xr = (row < 32768 ? xa + (size_t)row * 1024 : xb + (size_t)(row - 32768) * 1024) + col0; float* orow = out + (size_t)row * 1024 + col0;
#pragma unroll
                for (int bj = 0; bj < 2; ++bj)
#pragma unroll
                    for (int n = 0; n < 2; ++n) { const f32x4 xv = *(const f32x4*)(xr + bj * HALF + 4 * n);
                        *(f32x4*)(orow + bj * HALF + 4 * n) = xv * 1.189207115002721f + gv[bj][n] * acc[ai][bj][m][n]; } }
    }
};
struct EpiResidBf {
    static constexpr bool PERM = true, AFTER_DRAIN = false;
    const float* xa; const float* xb; bf16_t* out; const float* gate;
    __device__ __forceinline__ void operator()(const f32x4 (&acc)[2][2][4][2], const Unit& u, int wr, int wc, int fr, int fq) const {
        const int row0 = u.pm * BM + wr * 64 + fr; const int col0 = u.pn * BM + wc * 32 + 8 * fq;
        const int rb = u.pm * BM; const int bi = rb < 32768 ? (rb >> 11) : 16 + ((rb - 32768) >> 14);
        f32x4 gv[2][2];
#pragma unroll
        for (int bj = 0; bj < 2; ++bj)
#pragma unroll
            for (int n = 0; n < 2; ++n) gv[bj][n] = *(const f32x4*)(gate + (size_t)bi * 6144 + col0 + bj * HALF + 4 * n) + 1.0f;
#pragma unroll
        for (int ai = 0; ai < 2; ++ai)
#pragma unroll
            for (int m = 0; m < 4; ++m) { const int row = row0 + ai * HALF + m * 16;
                const float* xr = (row < 32768 ? xa + (size_t)row * 1024 : xb + (size_t)(row - 32768) * 1024) + col0; bf16_t* orow = out + (size_t)row * 1024 + col0;
#pragma unroll
                for (int bj = 0; bj < 2; ++bj) { const f32x4 x0 = *(const f32x4*)(xr + bj * HALF), x1 = *(const f32x4*)(xr + bj * HALF + 4);
                    const f32x4 v0 = x0 * 1.189207115002721f + gv[bj][0] * acc[ai][bj][m][0], v1 = x1 * 1.189207115002721f + gv[bj][1] * acc[ai][bj][m][1];
                    u32x4 w; w.x = cvt_pk_bf16(v0[0], v0[1]); w.y = cvt_pk_bf16(v0[2], v0[3]); w.z = cvt_pk_bf16(v1[0], v1[1]); w.w = cvt_pk_bf16(v1[2], v1[3]);
                    *(u32x4*)(orow + bj * HALF) = w; } }
    }
};
struct EpiResidLn {
    static constexpr bool PERM = true, AFTER_DRAIN = false;
    const bf16_t* y1; const float* stats; const float* lg; const float* lb; bf16_t* out; const float* gate;
    __device__ __forceinline__ void operator()(const f32x4 (&acc)[2][2][4][2], const Unit& u, int wr, int wc, int fr, int fq) const {
        const int row0 = u.pm * BM + wr * 64 + fr; const int col0 = u.pn * BM + wc * 32 + 8 * fq;
        const int rb = u.pm * BM; const int bi = rb < 32768 ? (rb >> 11) : 16 + ((rb - 32768) >> 14);
        f32x4 gv[2][2], lgv[2][2], lbv[2][2];
#pragma unroll
        for (int bj = 0; bj < 2; ++bj)
#pragma unroll
            for (int n = 0; n < 2; ++n) { gv[bj][n] = *(const f32x4*)(gate + (size_t)bi * 6144 + col0 + bj * HALF + 4 * n) + 1.0f;
                lgv[bj][n] = *(const f32x4*)(lg + col0 + bj * HALF + 4 * n) * 1.189207115002721f; lbv[bj][n] = *(const f32x4*)(lb + col0 + bj * HALF + 4 * n) * 1.189207115002721f; }
#pragma unroll
        for (int ai = 0; ai < 2; ++ai)
#pragma unroll
            for (int m = 0; m < 4; ++m) { const int row = row0 + ai * HALF + m * 16;
                const float mean = stats[2 * row], rstd = stats[2 * row + 1];
                const bf16_t* yr = y1 + (size_t)row * 1024 + col0; bf16_t* orow = out + (size_t)row * 1024 + col0;
#pragma unroll
                for (int bj = 0; bj < 2; ++bj) { f32x4 zv[2];
#pragma unroll
                    for (int n = 0; n < 2; ++n) { const u32x2 yw = *(const u32x2*)(yr + bj * HALF + 4 * n);
                        const f32x4 yv = {__builtin_bit_cast(float, yw.x << 16), __builtin_bit_cast(float, yw.x & 0xffff0000u), __builtin_bit_cast(float, yw.y << 16), __builtin_bit_cast(float, yw.y & 0xffff0000u)};
                        zv[n] = (yv - mean) * rstd * lgv[bj][n] + lbv[bj][n] + gv[bj][n] * acc[ai][bj][m][n]; }
                    u32x4 w; w.x = cvt_pk_bf16(zv[0][0], zv[0][1]); w.y = cvt_pk_bf16(zv[0][2], zv[0][3]); w.z = cvt_pk_bf16(zv[1][0], zv[1][1]); w.w = cvt_pk_bf16(zv[1][2], zv[1][3]);
                    *(u32x4*)(orow + bj * HALF) = w; } }
    }
};
template <class Epi, class Sched, bool ALIGN_EPI = false, bool SP2 = false>
__device__ __forceinline__ void gemm_phase(PG8_LAS unsigned char* lds, const Gemm g, const Sched& S, const Epi& E) {
    const int tid = opaque_tid(), wid = __builtin_amdgcn_readfirstlane(tid >> 6), lane = tid & 63, wr = wid >> 2, wc = wid & 3, fr = lane & 15, fq = lane >> 4;
    const int K = g.K, nt = K / BK, LD = g.ld ? g.ld : g.K; const size_t kwb = g.kwin ? (size_t)g.K * 2 : 0;
    unsigned voffA[2], voffB[2];
#pragma unroll
    for (int i = 0; i < 2; ++i) { int R, C; stage_rc(tid * 16 + i * 8192, R, C); const int Rb = Epi::PERM ? ((R & ~31) + perm32(R & 31)) : R;
        voffA[i] = (unsigned)(R * LD + C) * 2u; voffB[i] = (unsigned)(Rb * LD + C) * 2u; }
    const size_t kstep = (size_t)(BK * 2);
    const size_t hstep = (size_t)HALF * LD * 2;
    const size_t tstep = 2 * hstep;
    const unsigned ldsw = (unsigned)wid * 1024u;
    const int aoff = lds_byte(wr * 64 + fr, fq * 8), boff = lds_byte(wc * 32 + fr, fq * 8);
#define PG8_SA(b, h) (((b) * 2 + (h)) * HTB)
#define PG8_SB(b, h) ((4 + (b) * 2 + (h)) * HTB)
#define PG8_STAGE(bufoff, gbase, voff) do { _Pragma("unroll") for (int _i = 0; _i < 2; ++_i) \
        __builtin_amdgcn_global_load_lds((const unsigned*)((const char*)(gbase) + (voff)[_i]), (PG8_LAS unsigned*)(lds + (bufoff) + ldsw + _i * 8192), 16, 0, 0); } while (0)
#define PG8_LDA(dst, b, h) do { _Pragma("unroll") for (int m = 0; m < 4; ++m) _Pragma("unroll") for (int k = 0; k < 2; ++k) dst[m][k] = *(const PG8_LAS bf16x8*)(lds + PG8_SA(b, h) + aoff + m * 2048 + k * 1024); } while (0)
#define PG8_LDB(dst, b, h) do { _Pragma("unroll") for (int n = 0; n < 2; ++n) _Pragma("unroll") for (int k = 0; k < 2; ++k) dst[n][k] = *(const PG8_LAS bf16x8*)(lds + PG8_SB(b, h) + boff + n * 2048 + k * 1024); } while (0)
#define PG8_MMA(ai, bj, At, Bt) do { __builtin_amdgcn_s_setprio(1); _Pragma("unroll") for (int m = 0; m < 4; ++m) _Pragma("unroll") for (int n = 0; n < 2; ++n) _Pragma("unroll") for (int k = 0; k < 2; ++k) \
        acc[ai][bj][m][n] = __builtin_amdgcn_mfma_f32_16x16x32_bf16(Bt[n][k], At[m][k], acc[ai][bj][m][n], 0, 0, 0); __builtin_amdgcn_s_setprio(0); } while (0)
#define PG8_WAIT_V(n) asm volatile("s_waitcnt vmcnt(" #n ")" ::: "memory")
#define PG8_WAIT_L(n) asm volatile("s_waitcnt lgkmcnt(" #n ")" ::: "memory")
#define PG8_BAR __builtin_amdgcn_s_barrier()
#define PG8_SCHED __builtin_amdgcn_sched_barrier(0)
    Unit cur, nxt; int ui = 0;
    if (!S.next(0, cur)) return;
    f32x4 acc[2][2][4][2];
#pragma unroll
    for (int a = 0; a < 2; ++a)
#pragma unroll
        for (int b = 0; b < 2; ++b)
#pragma unroll
            for (int m = 0; m < 4; ++m)
#pragma unroll
                for (int n = 0; n < 2; ++n) acc[a][b][m][n] = (f32x4){0.f, 0.f, 0.f, 0.f};
    bf16x8 At[4][2], B0[2][2], B1[2][2];
    const char* cA = (const char*)g.A + (size_t)cur.pm * tstep + (size_t)cur.pn * kwb; const char* cB = (const char*)g.Bt + (size_t)cur.pn * tstep + (size_t)cur.pn * kwb;
    S.a_ready(cur);
    if constexpr (SP2) {
        PG8_STAGE(PG8_SB(0, 0), cB, voffB); PG8_STAGE(PG8_SB(0, 1), cB + hstep, voffB); PG8_STAGE(PG8_SA(0, 0), cA, voffA); PG8_STAGE(PG8_SA(0, 1), cA + hstep, voffA);
        if (wr == 1) PG8_BAR;
        PG8_WAIT_V(2); PG8_BAR;
        PG8_STAGE(PG8_SB(1, 0), cB + kstep, voffB); PG8_STAGE(PG8_SA(1, 0), cA + kstep, voffA); PG8_STAGE(PG8_SB(1, 1), cB + hstep + kstep, voffB);
        PG8_WAIT_V(6); PG8_BAR;
    } else {
        PG8_STAGE(PG8_SB(0, 0), cB, voffB); PG8_STAGE(PG8_SA(0, 0), cA, voffA); PG8_STAGE(PG8_SB(0, 1), cB + hstep, voffB); PG8_STAGE(PG8_SA(0, 1), cA + hstep, voffA);
        if (wr == 1) PG8_BAR;
        PG8_WAIT_V(4); PG8_BAR;
        PG8_STAGE(PG8_SB(1, 0), cB + kstep, voffB); PG8_STAGE(PG8_SA(1, 0), cA + kstep, voffA); PG8_STAGE(PG8_SB(1, 1), cB + hstep + kstep, voffB);
        PG8_WAIT_V(6); PG8_BAR;
    }
    for (;;) {
        const bool has_next = S.next(ui + 1, nxt);
        const char* nA = has_next ? (const char*)g.A + (size_t)nxt.pm * tstep + (size_t)nxt.pn * kwb : cA; const char* nB = has_next ? (const char*)g.Bt + (size_t)nxt.pn * tstep + (size_t)nxt.pn * kwb : cB;
        for (int t = 0; t < nt; t += 2) {
            const bool last = (t == nt - 2);
            const char* a1 = cA + (size_t)(t + 1) * kstep;
            const char* a2 = last ? nA : cA + (size_t)(t + 2) * kstep; const char* b2 = last ? nB : cB + (size_t)(t + 2) * kstep;
            const char* a3 = a2 + kstep; const char* b3 = b2 + kstep;
            if (last && has_next) S.a_ready(nxt);
            if constexpr (SP2) {
            PG8_LDB(B0, 0, 0); PG8_LDB(B1, 0, 1); PG8_SCHED; PG8_LDA(At, 0, 0); PG8_STAGE(PG8_SA(1, 1), a1 + hstep, voffA);
            PG8_WAIT_V(8); PG8_WAIT_L(0); PG8_BAR; PG8_MMA(0, 0, At, B0); PG8_MMA(0, 1, At, B1); PG8_BAR; PG8_SCHED;
            PG8_LDA(At, 0, 1); PG8_STAGE(PG8_SB(0, 0), b2, voffB); PG8_STAGE(PG8_SB(0, 1), b2 + hstep, voffB); PG8_STAGE(PG8_SA(0, 0), a2, voffA);
            PG8_WAIT_V(8); PG8_WAIT_L(0); PG8_BAR; PG8_MMA(1, 0, At, B0); PG8_MMA(1, 1, At, B1); PG8_BAR; PG8_SCHED;
            PG8_LDB(B0, 1, 0); PG8_LDB(B1, 1, 1); PG8_SCHED; PG8_LDA(At, 1, 0); PG8_STAGE(PG8_SA(0, 1), a2 + hstep, voffA);
            PG8_WAIT_V(8); PG8_WAIT_L(0); PG8_BAR; PG8_MMA(0, 0, At, B0); PG8_MMA(0, 1, At, B1); PG8_BAR; PG8_SCHED;
            PG8_LDA(At, 1, 1); PG8_STAGE(PG8_SB(1, 0), b3, voffB); PG8_STAGE(PG8_SB(1, 1), b3 + hstep, voffB); PG8_STAGE(PG8_SA(1, 0), a3, voffA);
            PG8_WAIT_V(8); PG8_WAIT_L(0); PG8_BAR; PG8_MMA(1, 0, At, B0); PG8_MMA(1, 1, At, B1); PG8_BAR; PG8_SCHED;
            } else {
            PG8_LDB(B0, 0, 0); PG8_SCHED; PG8_LDA(At, 0, 0); PG8_STAGE(PG8_SA(1, 1), a1 + hstep, voffA);
            PG8_WAIT_L(8); PG8_BAR; PG8_WAIT_L(0); PG8_MMA(0, 0, At, B0); PG8_BAR; PG8_SCHED;
            PG8_LDB(B1, 0, 1); PG8_STAGE(PG8_SB(0, 0), b2, voffB);
            PG8_BAR; PG8_WAIT_L(0); PG8_MMA(0, 1, At, B1); PG8_BAR;
            PG8_LDA(At, 0, 1); PG8_STAGE(PG8_SA(0, 0), a2, voffA);
            PG8_BAR; PG8_WAIT_L(0); PG8_MMA(1, 0, At, B0); PG8_BAR; PG8_SCHED;
            PG8_STAGE(PG8_SB(0, 1), b2 + hstep, voffB);
            PG8_WAIT_V(6); PG8_BAR; PG8_MMA(1, 1, At, B1); PG8_BAR;
            PG8_LDB(B0, 1, 0); PG8_SCHED; PG8_LDA(At, 1, 0); PG8_STAGE(PG8_SA(0, 1), a2 + hstep, voffA);
            PG8_WAIT_L(8); PG8_BAR; PG8_WAIT_L(0); PG8_MMA(0, 0, At, B0); PG8_BAR; PG8_SCHED;
            PG8_LDB(B1, 1, 1); PG8_STAGE(PG8_SB(1, 0), b3, voffB);
            PG8_BAR; PG8_WAIT_L(0); PG8_MMA(0, 1, At, B1); PG8_BAR;
            PG8_LDA(At, 1, 1); PG8_STAGE(PG8_SA(1, 0), a3, voffA);
            PG8_BAR; PG8_WAIT_L(0); PG8_MMA(1, 0, At, B0); PG8_BAR; PG8_SCHED;
            PG8_STAGE(PG8_SB(1, 1), b3 + hstep, voffB);
            PG8_WAIT_V(6); PG8_BAR; PG8_MMA(1, 1, At, B1); PG8_BAR;
            }
        }
        if constexpr (ALIGN_EPI) { if (wr == 0) PG8_BAR; }
        if constexpr (!Epi::AFTER_DRAIN) { E(acc, cur, wr, wc, fr, fq); S.done(cur); }
        if (!has_next) break;
#pragma unroll
        for (int a = 0; a < 2; ++a)
#pragma unroll
            for (int b = 0; b < 2; ++b)
#pragma unroll
                for (int m = 0; m < 4; ++m)
#pragma unroll
                    for (int n = 0; n < 2; ++n) acc[a][b][m][n] = (f32x4){0.f, 0.f, 0.f, 0.f};
        cur = nxt; cA = nA; cB = nB; ++ui;
        if constexpr (ALIGN_EPI) { if (wr == 1) PG8_BAR; }
    }
    PG8_WAIT_V(0);
    if constexpr (!ALIGN_EPI) { if (wr == 0) PG8_BAR; }
    PG8_BAR;
    if constexpr (Epi::AFTER_DRAIN) { E.fused(acc, cur, wr, wc, fr, fq, lds, wid, lane); S.done(cur); }
#undef PG8_SA
#undef PG8_SB
#undef PG8_STAGE
#undef PG8_LDA
#undef PG8_LDB
#undef PG8_MMA
#undef PG8_WAIT_V
#undef PG8_WAIT_L
#undef PG8_BAR
#undef PG8_SCHED
}
}
namespace att {
using bf16x8 = __attribute__((ext_vector_type(8))) short;
using s16x4  = __attribute__((ext_vector_type(4))) short;
using f32x16 = __attribute__((ext_vector_type(16))) float;
using u32x4  = __attribute__((ext_vector_type(4))) unsigned;
constexpr int KVBLK = 64, LDK = 512;
constexpr float SCALE = 0.125f;
constexpr float THR = 8.f;
constexpr int SHM_V = 16384, SHM_K = 16384;
#define KSWZ(row, colB) ((row) * 256 + ((colB) ^ (((row) & 15) << 4)))
#define SBAR() __builtin_amdgcn_sched_barrier(0)
__device__ __forceinline__ int crow(int r, int hi) { return (r & 3) + 8 * (r >> 2) + 4 * hi; }
__device__ __forceinline__ unsigned cvtpk(float lo, float hi) { unsigned r; asm volatile("v_cvt_pk_bf16_f32 %0, %1, %2" : "=v"(r) : "v"(lo), "v"(hi)); return r; }

__device__ __forceinline__ void partialSM(f32x16& p0, f32x16& p1, float& m_reg, float& mn, float& alpha) {
  constexpr float C = SCALE * 1.4426950408889634f;
  float pmax = p0[0];
#pragma unroll
  for (int r = 1; r < 16; ++r) pmax = fmaxf(pmax, p0[r]);
#pragma unroll
  for (int r = 0; r < 16; ++r) pmax = fmaxf(pmax, p1[r]);
  { auto rr = __builtin_amdgcn_permlane32_swap(__float_as_uint(pmax), __float_as_uint(pmax), false, false);
    pmax = fmaxf(__uint_as_float(rr[0]), __uint_as_float(rr[1])); }
  if (__builtin_expect(__all(pmax - m_reg <= THR / SCALE), 1)) { mn = m_reg; alpha = 1.f; }
  else { mn = fmaxf(m_reg, pmax); alpha = __builtin_amdgcn_exp2f((m_reg - mn) * C); m_reg = mn; }
  float mnC = -mn * C;
#pragma unroll
  for (int r = 0; r < 16; ++r) p0[r] = fmaf(p0[r], C, mnC);
#pragma unroll
  for (int r = 0; r < 16; ++r) p1[r] = fmaf(p1[r], C, mnC);
#pragma unroll
  for (int r = 0; r < 16; ++r) p0[r] = __builtin_amdgcn_exp2f(p0[r]);
}
__device__ __forceinline__ void finishSM(f32x16& p0, f32x16& p1, float alpha, float& l_reg, bf16x8& pa0, bf16x8& pa1, bf16x8& pa2, bf16x8& pa3) {
#pragma unroll
  for (int r = 0; r < 16; ++r) p1[r] = __builtin_amdgcn_exp2f(p1[r]);
  float ps = 0;
#pragma unroll
  for (int r = 0; r < 16; ++r) ps += p0[r];
#pragma unroll
  for (int r = 0; r < 16; ++r) ps += p1[r];
  { auto rr = __builtin_amdgcn_permlane32_swap(__float_as_uint(ps), __float_as_uint(ps), false, false);
    ps = __uint_as_float(rr[0]) + __uint_as_float(rr[1]); }
  l_reg = l_reg * alpha + ps;
#define PK4(P, BASE, OUT) do { unsigned a0 = cvtpk(P[BASE + 0], P[BASE + 1]), a1 = cvtpk(P[BASE + 2], P[BASE + 3]);   \
    unsigned b0 = cvtpk(P[BASE + 4], P[BASE + 5]), b1 = cvtpk(P[BASE + 6], P[BASE + 7]);                              \
    auto r0 = __builtin_amdgcn_permlane32_swap(a0, b0, false, false); auto r1 = __builtin_amdgcn_permlane32_swap(a1, b1, false, false); \
    u32x4 w = {r0[0], r1[0], r0[1], r1[1]}; OUT = *reinterpret_cast<bf16x8*>(&w); } while (0)
  PK4(p0, 0, pa0); PK4(p0, 8, pa1); PK4(p1, 0, pa2); PK4(p1, 8, pa3);
#undef PK4
}
__device__ __forceinline__ void qkt(f32x16& p0, f32x16& p1, const char* Ks, const bf16x8* qr, int r32, int hi, int cmap) {
  p0 = f32x16{}; p1 = f32x16{};
#pragma unroll
  for (int d0 = 0; d0 < 4; ++d0) { int cb = (cmap * 64 + d0 * 16 + hi * 8) * 2;
    bf16x8 b0 = *reinterpret_cast<const bf16x8*>(Ks + KSWZ(r32, cb));
    bf16x8 b1 = *reinterpret_cast<const bf16x8*>(Ks + KSWZ(32 + r32, cb));
    p0 = __builtin_amdgcn_mfma_f32_32x32x16_bf16(b0, qr[d0], p0, 0, 0, 0);
    p1 = __builtin_amdgcn_mfma_f32_32x32x16_bf16(b1, qr[d0], p1, 0, 0, 0); }
}
__device__ __forceinline__ void qkt_load(bf16x8 (&kf)[8], const char* Ks, int r32, int hi, int cmap) {
#pragma unroll
  for (int d0 = 0; d0 < 4; ++d0) { int cb = (cmap * 64 + d0 * 16 + hi * 8) * 2;
    kf[2 * d0] = *reinterpret_cast<const bf16x8*>(Ks + KSWZ(r32, cb)); kf[2 * d0 + 1] = *reinterpret_cast<const bf16x8*>(Ks + KSWZ(32 + r32, cb)); }
}
__device__ __forceinline__ void qkt_mma(f32x16& p0, f32x16& p1, const bf16x8 (&kf)[8], const bf16x8* qr) {
  p0 = f32x16{}; p1 = f32x16{};
#pragma unroll
  for (int d0 = 0; d0 < 4; ++d0) { p0 = __builtin_amdgcn_mfma_f32_32x32x16_bf16(kf[2 * d0], qr[d0], p0, 0, 0, 0); p1 = __builtin_amdgcn_mfma_f32_32x32x16_bf16(kf[2 * d0 + 1], qr[d0], p1, 0, 0, 0); }
}
__device__ __forceinline__ int v_st(int k, int c) { const int kk = (k & ~0xC) | ((k & 4) << 1) | ((k & 8) >> 1); return ((kk >> 3) * 4 + (c >> 5)) * 512 + ((kk & 7) * 32 + (c & 31)) * 2; }
__device__ __forceinline__ int v_rd_base(int lane) { return ((lane & 3) << 3) | (((lane >> 2) & 3) << 6) | (((lane >> 4) & 1) << 5) | (((lane >> 5) & 1) << 8); }
constexpr int v_rd_off(int d0, int ks, int half) { return d0 * 512 + ks * 4096 + half * 2048; }
template <int OFF> __device__ __forceinline__ s16x4 tr_read(int vb) {
  s16x4 r; asm volatile("ds_read_b64_tr_b16 %0, %1 offset:%2" : "=&v"(r) : "v"(vb), "i"(OFF) : "memory"); return r;
}
struct VF { s16x4 l0, h0, l1, h1, l2, h2, l3, h3; };
template <int D0> __device__ __forceinline__ void vf_issue(VF& f, int vb) {
  f.l0 = tr_read<v_rd_off(D0, 0, 0)>(vb); f.h0 = tr_read<v_rd_off(D0, 0, 1)>(vb); f.l1 = tr_read<v_rd_off(D0, 1, 0)>(vb); f.h1 = tr_read<v_rd_off(D0, 1, 1)>(vb);
  f.l2 = tr_read<v_rd_off(D0, 2, 0)>(vb); f.h2 = tr_read<v_rd_off(D0, 2, 1)>(vb); f.l3 = tr_read<v_rd_off(D0, 3, 0)>(vb); f.h3 = tr_read<v_rd_off(D0, 3, 1)>(vb);
}
#define PKF(L, H) (bf16x8){L[0], L[1], L[2], L[3], H[0], H[1], H[2], H[3]}
#define MMA4(od, f) do { od = __builtin_amdgcn_mfma_f32_32x32x16_bf16(pa0, PKF(f.l0, f.h0), od, 0, 0, 0); od = __builtin_amdgcn_mfma_f32_32x32x16_bf16(pa1, PKF(f.l1, f.h1), od, 0, 0, 0); \
    od = __builtin_amdgcn_mfma_f32_32x32x16_bf16(pa2, PKF(f.l2, f.h2), od, 0, 0, 0); od = __builtin_amdgcn_mfma_f32_32x32x16_bf16(pa3, PKF(f.l3, f.h3), od, 0, 0, 0); } while (0)
#define PIN(x) asm volatile("" : "+v"(x))
#define WAIT_LGKM(n) asm volatile("s_waitcnt lgkmcnt(" #n ")" ::: "memory")
__device__ __forceinline__ float sm_rowmax(const f32x16& p0, const f32x16& p1) {
  float pmax = p0[0];
#pragma unroll
  for (int r = 1; r < 16; ++r) pmax = fmaxf(pmax, p0[r]);
#pragma unroll
  for (int r = 0; r < 16; ++r) pmax = fmaxf(pmax, p1[r]);
  auto rr = __builtin_amdgcn_permlane32_swap(__float_as_uint(pmax), __float_as_uint(pmax), false, false);
  return fmaxf(__uint_as_float(rr[0]), __uint_as_float(rr[1]));
}
__device__ __forceinline__ void sm_scale(f32x16& p0, f32x16& p1, float pmax, float& m_reg, float& alpha, bool& zero) {
  constexpr float THR2 = THR * 1.4426950408889634f;
  alpha = 1.f;
  if (__builtin_expect(!__all(pmax - m_reg <= THR2), 0)) { const float mn = fmaxf(m_reg, pmax); alpha = __builtin_amdgcn_exp2f(m_reg - mn); m_reg = mn; zero = false; }
  if (__builtin_expect(!zero, 0)) {
#pragma unroll
    for (int r = 0; r < 16; ++r) { p0[r] -= m_reg; p1[r] -= m_reg; }
  }
}
__device__ __forceinline__ void sm_exp(f32x16& p) {
#pragma unroll
  for (int r = 0; r < 16; ++r) p[r] = __builtin_amdgcn_exp2f(p[r]);
}
__device__ __forceinline__ void sm_finish(const f32x16& p0, const f32x16& p1, float alpha, float& l_reg, bf16x8& pa0, bf16x8& pa1, bf16x8& pa2, bf16x8& pa3) {
  float ps = 0;
#pragma unroll
  for (int r = 0; r < 16; ++r) ps += p0[r];
#pragma unroll
  for (int r = 0; r < 16; ++r) ps += p1[r];
  { auto rr = __builtin_amdgcn_permlane32_swap(__float_as_uint(ps), __float_as_uint(ps), false, false);
    ps = __uint_as_float(rr[0]) + __uint_as_float(rr[1]); }
  l_reg = l_reg * alpha + ps;
#define PK8(P, BASE, OUT) do { u32x4 w = {cvtpk(P[BASE + 0], P[BASE + 1]), cvtpk(P[BASE + 2], P[BASE + 3]), cvtpk(P[BASE + 4], P[BASE + 5]), cvtpk(P[BASE + 6], P[BASE + 7])}; \
    OUT = *reinterpret_cast<bf16x8*>(&w); } while (0)
  PK8(p0, 0, pa0); PK8(p0, 8, pa1); PK8(p1, 0, pa2); PK8(p1, 8, pa3);
#undef PK8
}
__device__ __forceinline__ unsigned short f2bf(float f) { unsigned u = __builtin_bit_cast(unsigned, f); return (unsigned short)((u + 0x7fffu + ((u >> 16) & 1u)) >> 16); }

__device__ __forceinline__ float sm_rowsum(const f32x16& p0, const f32x16& p1) {
  float ps = 0;
#pragma unroll
  for (int r = 0; r < 16; ++r) ps += p0[r];
#pragma unroll
  for (int r = 0; r < 16; ++r) ps += p1[r];
  auto rr = __builtin_amdgcn_permlane32_swap(__float_as_uint(ps), __float_as_uint(ps), false, false);
  return __uint_as_float(rr[0]) + __uint_as_float(rr[1]);
}
__device__ __forceinline__ void sm_pack(const f32x16& p0, const f32x16& p1, bf16x8& pa0, bf16x8& pa1, bf16x8& pa2, bf16x8& pa3) {
#define PK8(P, BASE, OUT) do { u32x4 w = {cvtpk(P[BASE + 0], P[BASE + 1]), cvtpk(P[BASE + 2], P[BASE + 3]), cvtpk(P[BASE + 4], P[BASE + 5]), cvtpk(P[BASE + 6], P[BASE + 7])}; \
    OUT = *reinterpret_cast<bf16x8*>(&w); } while (0)
  PK8(p0, 0, pa0); PK8(p0, 8, pa1); PK8(p1, 0, pa2); PK8(p1, 8, pa3);
#undef PK8
}
template <int LO, int HI> __device__ __forceinline__ void sm_exp_rng(f32x16& p0, f32x16& p1) {
#pragma unroll
  for (int i = LO; i < HI; ++i) { if (i < 16) p0[i] = __builtin_amdgcn_exp2f(p0[i]); else p1[i - 16] = __builtin_amdgcn_exp2f(p1[i - 16]); }
}
__device__ __forceinline__ void glds16(const void* gsrc, unsigned lds_dst) { unsigned keep;
  asm volatile("s_mov_b32 %0, m0\n\ts_mov_b32 m0, %2\n\ts_nop 0\n\tglobal_load_lds_dwordx4 %1, off\n\ts_mov_b32 m0, %0" : "=&s"(keep) : "v"(gsrc), "s"(lds_dst) : "memory"); }
#define WAIT_BAR(N) asm volatile("s_waitcnt vmcnt(" #N ") lgkmcnt(0)\n\ts_barrier" ::: "memory")
template <bool FAST>
__device__ __forceinline__ bool attn_unit(const bf16_t* __restrict__ Qb, const bf16_t* __restrict__ Kh, const bf16_t* __restrict__ Vh,
                                          bf16_t* __restrict__ Ob, int seq, char* lds, float lam, const float* __restrict__ subg) {
  const int tid = opaque_tid(), wid = tid >> 6, lane = tid & 63, r32 = lane & 31, hi = lane >> 5;
  const int qg = wid & 3, cmap = wid >> 2;
  constexpr int BUFB = 32768;
  float* ws = (float*)(lds + 4 * BUFB) + wid * 64; float* li_l = ws; float* al_l = ws + 32;
  float m_reg = 0.f, l_reg = 0; bool zero = true; f32x16 o[4] = {}; bf16x8 qr[4];
  const bf16_t* Qw = Qb + (long)(qg * 32 + r32) * LDK + cmap * 64 + hi * 8;
#pragma unroll
  for (int d0 = 0; d0 < 4; ++d0) qr[d0] = *reinterpret_cast<const bf16x8*>(Qw + d0 * 16);
  const unsigned lds0 = (unsigned)(uintptr_t)lds;
  const int vb0 = (int)lds0 + v_rd_base(lane);
  int koff[2], voff[2];
#pragma unroll
  for (int i = 0; i < 2; ++i) { const int c = wid + 8 * i;
    { const int row = 4 * c + (lane >> 4), sch = (lane & 15) ^ (row & 15); koff[i] = row * LDK + sch * 8; }
    { const int st = 2 * c + (lane >> 5), kk = (st >> 2) * 8 + ((lane & 31) >> 2), k = kk, col = (st & 3) * 32 + (lane & 3) * 8; voff[i] = k * LDK + col; } }
  const unsigned dstw = lds0 + (unsigned)wid * 1024u;
#define DMA_TILE(t, boff) do { const bf16_t* kt_ = Kh + (long)(t) * (KVBLK * LDK); const bf16_t* vt_ = Vh + (long)(t) * (KVBLK * LDK); \
    const unsigned d_ = (unsigned)__builtin_amdgcn_readfirstlane((int)(dstw + (unsigned)(boff))); \
    glds16(kt_ + koff[0], d_ + 16384u); glds16(kt_ + koff[1], d_ + 16384u + 8192u); glds16(vt_ + voff[0], d_); glds16(vt_ + voff[1], d_ + 8192u); } while (0)
#define RESC(a) do { if (__any((a) < 1.f)) { if (hi == 0) al_l[r32] = (a); asm volatile("s_waitcnt lgkmcnt(0)" ::: "memory"); \
    _Pragma("unroll") for (int d = 0; d < 4; ++d) _Pragma("unroll") for (int r = 0; r < 16; ++r) o[d][r] *= al_l[crow(r, hi)]; } } while (0)
  f32x16 pA0, pA1, pB0, pB1; float alA, alB; bf16x8 pa0, pa1, pa2, pa3; const int NT = seq / KVBLK;
  int kv_prev = 0, kv_cur = BUFB, kv_n1 = 2 * BUFB, kv_n2 = 3 * BUFB;
  asm volatile("s_waitcnt vmcnt(0)" ::: "memory");
  DMA_TILE(0, 0); DMA_TILE(1, BUFB); DMA_TILE(2, 2 * BUFB);
  WAIT_BAR(8);
  qkt(pA0, pA1, lds + 16384, qr, r32, hi, cmap);
  alA = 1.f; alB = 1.f;
  if constexpr (FAST) { sm_exp(pA0); sm_exp(pA1); }
  else { const float pm = sm_rowmax(pA0, pA1);
    if (!__all(fabsf(pm) <= THR * 1.4426950408889634f)) { m_reg = pm; zero = false; }
    if (!zero) {
#pragma unroll
      for (int r = 0; r < 16; ++r) { pA0[r] -= m_reg; pA1[r] -= m_reg; } }
    sm_exp(pA0); sm_exp(pA1); }
  WAIT_BAR(4);
#define STEP_SLOW(C0, C1, P0, P1, alC, alP, LDCOND, LDT) do { \
    const bool ld_ = (LDCOND); if (ld_) DMA_TILE(LDT, kv_n2); SBAR(); \
    const int vb = vb0 + kv_prev; VF fa, fb; \
    vf_issue<0>(fa, vb); SBAR(); \
    qkt(C0, C1, lds + kv_cur + 16384, qr, r32, hi, cmap); \
    sm_finish(P0, P1, alP, l_reg, pa0, pa1, pa2, pa3); SBAR(); \
    vf_issue<1>(fb, vb); WAIT_LGKM(8); SBAR(); \
    MMA4(o[0], fa); float pm_ = sm_rowmax(C0, C1); PIN(pm_); SBAR(); \
    vf_issue<2>(fa, vb); WAIT_LGKM(8); SBAR(); \
    MMA4(o[1], fb); sm_scale(C0, C1, pm_, m_reg, alC, zero); PIN(C0); PIN(C1); SBAR(); \
    vf_issue<3>(fb, vb); WAIT_LGKM(8); SBAR(); \
    MMA4(o[2], fa); sm_exp(C0); PIN(C0); SBAR(); \
    WAIT_LGKM(0); SBAR(); \
    MMA4(o[3], fb); sm_exp(C1); PIN(C1); SBAR(); \
    RESC(alC); \
    if (ld_) WAIT_BAR(4); else WAIT_BAR(0); \
    { const int t_ = kv_prev; kv_prev = kv_cur; kv_cur = kv_n1; kv_n1 = kv_n2; kv_n2 = t_; } } while (0)
#define STEP_FAST(C0, C1, P0, P1, LDCOND, LDT) do { \
    const bool ld_ = (LDCOND); if (ld_) DMA_TILE(LDT, kv_n2); SBAR(); \
    const int vb = vb0 + kv_prev; VF fa, fb; \
    vf_issue<0>(fa, vb); SBAR(); \
    bf16x8 kf_[8]; qkt_load(kf_, lds + kv_cur + 16384, r32, hi, cmap); SBAR(); \
    l_reg += sm_rowsum(P0, P1); PIN(l_reg); SBAR();                \
    qkt_mma(C0, C1, kf_, qr); sm_pack(P0, P1, pa0, pa1, pa2, pa3); SBAR(); \
    vf_issue<1>(fb, vb); WAIT_LGKM(8); SBAR(); \
    MMA4(o[0], fa); sm_exp_rng<0, 8>(C0, C1); PIN(C0); SBAR(); \
    vf_issue<2>(fa, vb); WAIT_LGKM(8); SBAR(); \
    MMA4(o[1], fb); sm_exp_rng<8, 16>(C0, C1); PIN(C0); SBAR(); \
    vf_issue<3>(fb, vb); WAIT_LGKM(8); SBAR(); \
    MMA4(o[2], fa); sm_exp_rng<16, 24>(C0, C1); PIN(C1); SBAR(); \
    WAIT_LGKM(0); SBAR(); \
    MMA4(o[3], fb); sm_exp_rng<24, 32>(C0, C1); PIN(C1); SBAR(); \
    if (ld_) WAIT_BAR(4); else WAIT_BAR(0); \
    { const int t_ = kv_prev; kv_prev = kv_cur; kv_cur = kv_n1; kv_n1 = kv_n2; kv_n2 = t_; } } while (0)
#define STEP(C0, C1, P0, P1, alC, alP, LDCOND, LDT) do { if constexpr (FAST) STEP_FAST(C0, C1, P0, P1, LDCOND, LDT); else STEP_SLOW(C0, C1, P0, P1, alC, alP, LDCOND, LDT); } while (0)
  for (int j = 1; j + 1 < NT; j += 2) {
    STEP(pB0, pB1, pA0, pA1, alB, alA, (j + 2 < NT), j + 2);
    STEP(pA0, pA1, pB0, pB1, alA, alB, (j + 3 < NT), j + 3);
  }
  STEP(pB0, pB1, pA0, pA1, alB, alA, false, 0);
  {
    const int vb = vb0 + kv_prev; VF fa, fb;
    vf_issue<0>(fa, vb); SBAR();
    if constexpr (FAST) { l_reg += sm_rowsum(pB0, pB1); sm_pack(pB0, pB1, pa0, pa1, pa2, pa3); } else sm_finish(pB0, pB1, alB, l_reg, pa0, pa1, pa2, pa3);
    SBAR();
    vf_issue<1>(fb, vb); WAIT_LGKM(8); SBAR(); MMA4(o[0], fa); SBAR();
    vf_issue<2>(fa, vb); WAIT_LGKM(8); SBAR(); MMA4(o[1], fb); SBAR();
    vf_issue<3>(fb, vb); WAIT_LGKM(8); SBAR(); MMA4(o[2], fa); SBAR();
    WAIT_LGKM(0); SBAR(); MMA4(o[3], fb); SBAR();
  }
#undef STEP
#undef STEP_FAST
#undef STEP_SLOW
#undef DMA_TILE
  if constexpr (FAST) {
    const bool okw = __all(l_reg < 1.8446744e19f && l_reg > 5.4210109e-20f);
    if (lane == 0) li_l[63] = okw ? 1.f : 0.f;
    __syncthreads();
    bool ok = true;
#pragma unroll
    for (int w = 0; w < 8; ++w) ok = ok && (((const float*)(lds + 4 * BUFB))[w * 64 + 63] != 0.f);
    if (!ok) { __syncthreads(); return false; }
  }
  if (hi == 0) li_l[r32] = l_reg; asm volatile("s_waitcnt lgkmcnt(0)" ::: "memory");
  float rli[16];
#pragma unroll
  for (int r = 0; r < 16; ++r) rli[r] = __builtin_amdgcn_rcpf(li_l[crow(r, hi)]);
  __syncthreads();
  float* XB = (float*)lds + qg * (32 * 128);
  if (cmap == 1) {
#pragma unroll
    for (int r = 0; r < 16; ++r)
#pragma unroll
      for (int d0 = 0; d0 < 4; ++d0) XB[crow(r, hi) * 128 + d0 * 32 + r32] = o[d0][r] * rli[r] * (-lam);
  }
  __syncthreads();
  if (cmap == 0) {
    float gsc[4];
#pragma unroll
    for (int d0 = 0; d0 < 4; ++d0) gsc[d0] = subg[d0 * 32 + r32] * (1.0f - 0.2f);
#pragma unroll
    for (int r = 0; r < 16; ++r) { float v[4]; float ss = 0.f;
#pragma unroll
      for (int d0 = 0; d0 < 4; ++d0) { v[d0] = o[d0][r] * rli[r] + XB[crow(r, hi) * 128 + d0 * 32 + r32]; ss += v[d0] * v[d0]; }
      ss += __shfl_xor(ss, 1); ss += __shfl_xor(ss, 2); ss += __shfl_xor(ss, 4); ss += __shfl_xor(ss, 8); ss += __shfl_xor(ss, 16);
      const float rs = 1.0f / sqrtf(ss * (1.0f / 128.0f) + 1e-5f);
      bf16_t* orow = Ob + (long)(qg * 32 + crow(r, hi)) * 1024 + r32;
#pragma unroll
      for (int d0 = 0; d0 < 4; ++d0) orow[d0 * 32] = f2bf(v[d0] * rs * gsc[d0]); }
  }
  __syncthreads();
#undef RESC
  return true;
}
#undef KSWZ
#undef SBAR
}
struct Params { const float* in[21]; float* out; unsigned char* ws; float inv_freq[32]; };
enum { I_XP = 0, I_XS, I_CP, I_CS, I_WADA, I_BADA, I_WIN, I_LQ1, I_LK1, I_LQ2, I_LK2, I_SUBG, I_WF, I_WOUT, I_LN1G, I_LN1B, I_WG, I_WU, I_WD, I_LN2G, I_LN2B };

typedef float f32x4 __attribute__((ext_vector_type(4)));
typedef float f32x16 __attribute__((ext_vector_type(16)));
typedef short bf16x8 __attribute__((ext_vector_type(8)));
typedef short s16x4 __attribute__((ext_vector_type(4)));
typedef unsigned u32x4 __attribute__((ext_vector_type(4)));
typedef unsigned u32x2 __attribute__((ext_vector_type(2)));
#define LDS_WAIT() asm volatile("s_waitcnt lgkmcnt(0)" ::: "memory")

__device__ __forceinline__ unsigned f2bf(float f) { unsigned u = __builtin_bit_cast(unsigned, f); return (u + 0x7fffu + ((u >> 16) & 1u)) >> 16; }
__device__ __forceinline__ unsigned pk2(float lo, float hi) { return f2bf(lo) | (f2bf(hi) << 16); }
__device__ __forceinline__ float bf2f(unsigned short h) { return __builtin_bit_cast(float, (unsigned)h << 16); }
__device__ __forceinline__ float wave_sum(float v) {
#pragma unroll
    for (int o = 1; o < 64; o <<= 1) v += __shfl_xor(v, o);
    return v;
}
__device__ __forceinline__ int batch_of_row(int row) { return row < TOKP ? (row >> 11) : 16 + ((row - TOKP) >> 14); }

template <int MODE> __device__ __forceinline__ const float* src_col(const float* W0, const float* W1, int N0, int p, int& ldn) {
    if (MODE == 0) { ldn = N0; return W0 + p; }
    if (MODE == 1) { ldn = N0; int s = p;
        if (p < 1024) { const int w = p & 511, g64 = w >> 6, r = w & 63, j = r >> 3, e = r & 7; const int d = (e < 4) ? (4 * j + e) : (32 + 4 * j + (e - 4)); s = (p & ~511) + g64 * 64 + d; }
        return W0 + s; }
    { ldn = N0; const int g8 = p >> 3, e = p & 7; return (e < 4) ? (W0 + 4 * g8 + e) : (W1 + 4 * g8 + (e - 4)); }
}
template <int MODE> __device__ __forceinline__ void transpose_item(const float* W0, const float* W1, int K, int N0, int Np, bf16_t* WT, LAS float* scr, int item, int lane) {
    const int nblk = Np / 32, kb = item / nblk, nb = item % nblk, k0 = 64 * kb, n0 = 32 * nb;
    int ldn; const float* src = src_col<MODE>(W0, W1, N0, n0 + (lane & 31), ldn);
#pragma unroll 8
    for (int i = 0; i < 32; ++i) { const int kk = 2 * i + (lane >> 5); scr[kk * 33 + (lane & 31)] = src[(size_t)(k0 + kk) * ldn]; }
    LDS_WAIT(); asm volatile("" ::: "memory");
    const int c = lane & 7;
#pragma unroll
    for (int j = 0; j < 4; ++j) { const int n = (lane >> 3) + 8 * j; const LAS float* s = scr + (8 * c) * 33 + n;
        u32x4 o; o.x = pk2(s[0 * 33], s[1 * 33]); o.y = pk2(s[2 * 33], s[3 * 33]); o.z = pk2(s[4 * 33], s[5 * 33]); o.w = pk2(s[6 * 33], s[7 * 33]);
        *(u32x4*)(WT + (size_t)(n0 + n) * K + k0 + 8 * c) = o; }
    LDS_WAIT(); asm volatile("" ::: "memory");
}
__device__ __forceinline__ void sincos_acc(float ang, float& sn, float& cs) {
    const double x = (double)ang; const double n = __builtin_rint(x * 0.63661977236758134308);
    double r = __builtin_fma(-n, 1.57079632679489655800e+00, x); r = __builtin_fma(-n, 6.12323399573676603587e-17, r);
    const double r2 = r * r;
    const double sp = r2 * (-1.0 / 6 + r2 * (1.0 / 120 + r2 * (-1.0 / 5040 + r2 * (1.0 / 362880 + r2 * (-1.0 / 39916800 + r2 * (1.0 / 6227020800.0 + r2 * (-1.0 / 1307674368000.0)))))));
    const double ss = r + r * sp;
    const double cp = r2 * (-0.5 + r2 * (1.0 / 24 + r2 * (-1.0 / 720 + r2 * (1.0 / 40320 + r2 * (-1.0 / 3628800 + r2 * (1.0 / 479001600.0 + r2 * (-1.0 / 87178291200.0 + r2 * (1.0 / 20922789888000.0))))))));
    const double cc = 1.0 + cp; const int q = ((int)n) & 3;
    const double s_ = (q == 0) ? ss : (q == 1) ? cc : (q == 2) ? -ss : -cc;
    const double c_ = (q == 0) ? cc : (q == 1) ? -ss : (q == 2) ? -cc : ss;
    sn = (float)s_; cs = (float)c_;
}

__device__ __forceinline__ void p0_prologue(const Params& P, unsigned char* lds) {
    const int tid = threadIdx.x, lane = tid & 63, wave = tid >> 6, G = gridDim.x, bid = blockIdx.x;
    unsigned char* ws = P.ws;
    if (bid < 96) {
        float* sl = (float*)lds; float* red = sl + NBATCH * 1024;
        for (int i = tid; i < NBATCH * 1024; i += 512) { const int bi = i >> 10, d = i & 1023; const float c = bi < 16 ? P.in[I_CP][bi * 1024 + d] : P.in[I_CS][(bi - 16) * 1024 + d];
            sl[i] = c / (1.0f + __expf(-c)); }
        __syncthreads();
        for (int unit = bid; unit < 96; unit += G) {
            const int el = tid & 63, ds = tid >> 6, e = unit * 64 + el; float acc[NBATCH];
#pragma unroll
            for (int b = 0; b < NBATCH; ++b) acc[b] = 0.f;
            const float* wa = P.in[I_WADA] + e;
            for (int d = ds * 128; d < ds * 128 + 128; ++d) { const float w = wa[(size_t)d * NMOD];
#pragma unroll
                for (int b = 0; b < NBATCH; ++b) acc[b] += sl[b * 1024 + d] * w; }
#pragma unroll
            for (int b = 0; b < NBATCH; ++b) red[(ds * NBATCH + b) * 64 + el] = acc[b];
            __syncthreads();
            for (int o = tid; o < NBATCH * 64; o += 512) { const int b = o >> 6, e2 = o & 63; float s = P.in[I_BADA][unit * 64 + e2];
#pragma unroll
                for (int d2 = 0; d2 < 8; ++d2) s += red[(d2 * NBATCH + b) * 64 + e2];
                ((float*)(ws + WS_MOD))[b * NMOD + unit * 64 + e2] = s; }
            __syncthreads();
        }
    }
    __syncthreads();
    {
        LAS float* scr = (LAS float*)((LAS unsigned char*)lds + wave * 16384);
        const int gw = bid * 8 + wave, NGW = G * 8;
        constexpr int I_IN = (1024 / 64) * (2048 / 32), I_OUT = (1024 / 64) * (1024 / 32), I_GU = (1024 / 64) * (5632 / 32), I_DN = (2816 / 64) * (1024 / 32);
        for (int it = gw; it < I_IN + I_OUT + I_GU + I_DN; it += NGW) {
            int r = it;
            if (r < I_IN) { transpose_item<1>(P.in[I_WIN], nullptr, 1024, 2048, 2048, (bf16_t*)(ws + WS_WIN), scr, r, lane); continue; } r -= I_IN;
            if (r < I_OUT) { transpose_item<0>(P.in[I_WOUT], nullptr, 1024, 1024, 1024, (bf16_t*)(ws + WS_WOUT), scr, r, lane); continue; } r -= I_OUT;
            if (r < I_GU) { transpose_item<2>(P.in[I_WG], P.in[I_WU], 1024, 2816, 5632, (bf16_t*)(ws + WS_WGU), scr, r, lane); continue; } r -= I_GU;
            transpose_item<0>(P.in[I_WD], nullptr, 2816, 1024, 1024, (bf16_t*)(ws + WS_WDN), scr, r, lane);
        }
    }
    const int gt = bid * 512 + tid, NGT = G * 512;
    for (int i = gt; i < SEQ_S * 32; i += NGT) { const int s = i >> 5, k = i & 31; const float ang = (float)s * P.inv_freq[k]; float sn, cs; sincos_acc(ang, sn, cs);
        float* rp = (float*)(ws + WS_ROPE) + (size_t)s * 64; rp[k] = cs; rp[32 + k] = sn; }
    for (int i = gt; i < 128 * 128; i += NGT) { const int k = i >> 7, n = i & 127; const float fr = (float)((k * n) & 127) * (1.0f / 128.0f);
        const float c = __builtin_amdgcn_cosf(fr), s = __builtin_amdgcn_sinf(fr); bf16_t* t = (bf16_t*)(ws + WS_DFT);
        t[i] = (bf16_t)f2bf(c); t[16384 + i] = (bf16_t)f2bf(s); t[32768 + i] = (bf16_t)f2bf(-s); }
    for (int i = gt; i < 512 * 1024; i += NGT) { const int n = i >> 10, k = i & 1023, g = n >> 7, c = n & 127, g2 = k >> 8, ri = (k >> 7) & 1, c1 = k & 127; float v = 0.f;
        if (g == g2) { const float* wf = P.in[I_WF] + (size_t)g * 16384 + c; float a = 0.f;
            for (int j = 0; j < 128; ++j) { const float fr = (float)((c1 * j) & 127) * (1.0f / 128.0f); const float t = ri ? __builtin_amdgcn_sinf(fr) : __builtin_amdgcn_cosf(fr); a += t * wf[j * 128]; }
            v = a * 0.08838834764831845f; }
        ((bf16_t*)(ws + WS_WFD))[i] = (bf16_t)f2bf(v); }
}

__device__ __forceinline__ void ln_stats(f32x4 (&v)[4], float& mean, float& rstd) {
    float s = 0.f;
#pragma unroll
    for (int j = 0; j < 4; ++j) s += (v[j].x + v[j].y) + (v[j].z + v[j].w);
    mean = wave_sum(s) * (1.f / DM); float s2 = 0.f;
#pragma unroll
    for (int j = 0; j < 4; ++j) { v[j] = v[j] - mean; s2 += (v[j].x * v[j].x + v[j].y * v[j].y) + (v[j].z * v[j].z + v[j].w * v[j].w); }
    rstd = 1.f / sqrtf(wave_sum(s2) * (1.f / DM) + LN_EPS);
}
constexpr int RW = 4;
__device__ __forceinline__ void p1_lnmod(const Params& P) {
    const int lane = threadIdx.x & 63, gw = blockIdx.x * 8 + (threadIdx.x >> 6), NGW = gridDim.x * 8;
    const float* mod = (const float*)(P.ws + WS_MOD); bf16_t* H = (bf16_t*)(P.ws + WS_H1);
    for (int rb = gw * RW; rb < NTOK; rb += NGW * RW) {
        const float* mb = mod + (size_t)batch_of_row(rb) * NMOD;
        f32x4 v[RW][4]; float rstd[RW];
#pragma unroll
        for (int q = 0; q < RW; ++q) { const int row = rb + q; const float* xr = row < TOKP ? P.in[I_XP] + (size_t)row * DM : P.in[I_XS] + (size_t)(row - TOKP) * DM;
#pragma unroll
            for (int j = 0; j < 4; ++j) v[q][j] = ((const f32x4*)xr)[lane + 64 * j]; }
        f32x4 sh[4], sc[4];
#pragma unroll
        for (int j = 0; j < 4; ++j) { sh[j] = ((const f32x4*)mb)[lane + 64 * j]; sc[j] = ((const f32x4*)(mb + 1024))[lane + 64 * j] + 1.0f; }
#pragma unroll
        for (int q = 0; q < RW; ++q) { float mean; ln_stats(v[q], mean, rstd[q]); }
#pragma unroll
        for (int q = 0; q < RW; ++q) { unsigned long long* o8 = (unsigned long long*)(H + (size_t)(rb + q) * DM) + lane;
#pragma unroll
            for (int j = 0; j < 4; ++j) { const f32x4 h = v[q][j] * rstd[q] * sc[j] + sh[j];
                o8[64 * j] = (unsigned long long)pk2(h.x, h.y) | ((unsigned long long)pk2(h.z, h.w) << 32); } }
    }
}
__device__ __forceinline__ void p5_ln1(const Params& P) {
    const int lane = threadIdx.x & 63, gw = blockIdx.x * 8 + (threadIdx.x >> 6), NGW = gridDim.x * 8;
    const float* mod = (const float*)(P.ws + WS_MOD); bf16_t* H = (bf16_t*)(P.ws + WS_MIX); const bf16_t* Y = (const bf16_t*)(P.ws + WS_Y1);
    for (int rb = gw * RW; rb < NTOK; rb += NGW * RW) {
        const float* mb = mod + (size_t)batch_of_row(rb) * NMOD;
        f32x4 v[RW][4]; float rstd[RW];
#pragma unroll
        for (int q = 0; q < RW; ++q) { const bf16_t* yr = Y + (size_t)(rb + q) * DM;
#pragma unroll
            for (int j = 0; j < 4; ++j) { const u32x2 yw = ((const u32x2*)yr)[lane + 64 * j];
                v[q][j] = (f32x4){__builtin_bit_cast(float, yw.x << 16), __builtin_bit_cast(float, yw.x & 0xffff0000u), __builtin_bit_cast(float, yw.y << 16), __builtin_bit_cast(float, yw.y & 0xffff0000u)}; } }
#pragma unroll
        for (int q = 0; q < RW; ++q) { float mean; ln_stats(v[q], mean, rstd[q]); if (lane == 0) { float* st = (float*)(P.ws + WS_STAT) + 2 * (size_t)(rb + q); st[0] = mean; st[1] = rstd[q]; } }
#pragma unroll
        for (int j = 0; j < 4; ++j) { const f32x4 g = ((const f32x4*)P.in[I_LN1G])[lane + 64 * j], b = ((const f32x4*)P.in[I_LN1B])[lane + 64 * j];
#pragma unroll
            for (int q = 0; q < RW; ++q) v[q][j] = v[q][j] * rstd[q] * g + b; }
#pragma unroll
        for (int q = 0; q < RW; ++q) { float mean; ln_stats(v[q], mean, rstd[q]); }
#pragma unroll
        for (int j = 0; j < 4; ++j) { const f32x4 sh = ((const f32x4*)(mb + 3072))[lane + 64 * j], sc = ((const f32x4*)(mb + 4096))[lane + 64 * j] + 1.0f;
#pragma unroll
            for (int q = 0; q < RW; ++q) { const f32x4 h = v[q][j] * rstd[q] * sc + sh;
                ((unsigned long long*)(H + (size_t)(rb + q) * DM))[lane + 64 * j] = (unsigned long long)pk2(h.x, h.y) | ((unsigned long long)pk2(h.z, h.w) << 32); } }
    }
}
__device__ __forceinline__ void p8_ln2(const Params& P) {
    const int lane = threadIdx.x & 63, gw = blockIdx.x * 8 + (threadIdx.x >> 6), NGW = gridDim.x * 8;
    for (int rb = gw * RW; rb < NTOK; rb += NGW * RW) {
        f32x4 v[RW][4]; float rstd[RW];
#pragma unroll
        for (int q = 0; q < RW; ++q) { const bf16_t* zr = (const bf16_t*)(P.ws + WS_X) + (size_t)(rb + q) * DM;
#pragma unroll
            for (int j = 0; j < 4; ++j) { const u32x2 zw = ((const u32x2*)zr)[lane + 64 * j];
                v[q][j] = (f32x4){__builtin_bit_cast(float, zw.x << 16), __builtin_bit_cast(float, zw.x & 0xffff0000u), __builtin_bit_cast(float, zw.y << 16), __builtin_bit_cast(float, zw.y & 0xffff0000u)}; } }
#pragma unroll
        for (int q = 0; q < RW; ++q) { float mean; ln_stats(v[q], mean, rstd[q]); }
#pragma unroll
        for (int j = 0; j < 4; ++j) { const f32x4 g = ((const f32x4*)P.in[I_LN2G])[lane + 64 * j], b = ((const f32x4*)P.in[I_LN2B])[lane + 64 * j];
#pragma unroll
            for (int q = 0; q < RW; ++q) ((f32x4*)(P.out + (size_t)(rb + q) * DM))[lane + 64 * j] = v[q][j] * rstd[q] * g + b; }
    }
}

constexpr int FPB = 576;
typedef short v4i16_t __attribute__((ext_vector_type(4)));
__device__ __forceinline__ bf16x8 fft_bfrag(const LAS unsigned char* p) {
    const s16x4 lo = __builtin_bit_cast(s16x4, __builtin_amdgcn_ds_read_tr16_b64_v4i16((LAS v4i16_t*)p));
    const s16x4 hi = __builtin_bit_cast(s16x4, __builtin_amdgcn_ds_read_tr16_b64_v4i16((LAS v4i16_t*)(p + 4 * FPB)));
    return (bf16x8){lo[0], lo[1], lo[2], lo[3], hi[0], hi[1], hi[2], hi[3]};
}
__device__ __forceinline__ int crow16(int r, int hi) { return (r & 3) + 8 * (r >> 2) + 4 * hi; }

__device__ __forceinline__ void fa_sample_tile(const Params& P, unsigned char* lds, int tile) {
    const int tid = threadIdx.x, lane = tid & 63, wid = tid >> 6, r32 = lane & 31, hi = lane >> 5;
    const int g = tile & 3, n2p = (tile >> 2) & 63, b = tile >> 8;
    const bf16_t* U = (const bf16_t*)(P.ws + WS_Q) + (size_t)3 * NTOK * 512; bf16_t* YP = (bf16_t*)(P.ws + WS_YP);
    const size_t tok0 = (size_t)TOKP + (size_t)b * SEQ_S;
#pragma unroll
    for (int i = 0; i < 8; ++i) { const int c = tid + 512 * i, n1 = c >> 5, w = c & 31, t2 = w >> 4, c8 = w & 15;
        const u32x4 v = *(const u32x4*)(U + (tok0 + 128 * n1 + 2 * n2p + t2) * 512 + g * 128 + c8 * 8);
        *(u32x4*)(lds + n1 * FPB + (t2 * 128 + c8 * 8) * 2) = v; }
    __syncthreads();
    const int wm = wid & 3, wn = wid >> 2;
    const bf16_t* Wc = (const bf16_t*)(P.ws + WS_DFT); const bf16_t* Wn = Wc + 32768;
    const LAS unsigned char* lb = (const LAS unsigned char*)lds + (8 * hi + ((lane & 15) >> 2)) * FPB + (16 * ((lane >> 4) & 1) + 4 * (lane & 3)) * 2 + wn * 256;
    const int n2 = 2 * n2p + wn;
#pragma unroll 1
    for (int half = 0; half < 2; ++half) {
        f32x16 ar[2] = {}, ai[2] = {};
#pragma unroll 4
        for (int kk = 0; kk < 8; ++kk) {
            const bf16x8 fc = *(const bf16x8*)(Wc + (wm * 32 + r32) * 128 + kk * 16 + 8 * hi), fn = *(const bf16x8*)(Wn + (wm * 32 + r32) * 128 + kk * 16 + 8 * hi);
#pragma unroll
            for (int nb = 0; nb < 2; ++nb) { const bf16x8 bf = fft_bfrag(lb + kk * 16 * FPB + (half * 2 + nb) * 64);
                ar[nb] = __builtin_amdgcn_mfma_f32_32x32x16_bf16(fc, bf, ar[nb], 0, 0, 0); ai[nb] = __builtin_amdgcn_mfma_f32_32x32x16_bf16(fn, bf, ai[nb], 0, 0, 0); }
        }
#pragma unroll
        for (int r = 0; r < 16; ++r) { const int k1 = wm * 32 + crow16(r, hi); const float fr = (float)(k1 * n2) * (1.0f / 16384.0f);
            const float tc = __builtin_amdgcn_cosf(fr) * (1.0f / 128.0f), ts = __builtin_amdgcn_sinf(fr) * (1.0f / 128.0f);
            bf16_t* yrow = YP + (tok0 + (size_t)k1 * 128 + n2) * 1024 + g * 256 + half * 64 + r32;
#pragma unroll
            for (int nb = 0; nb < 2; ++nb) { const float yr = ar[nb][r], yi = ai[nb][r];
                yrow[nb * 32] = (bf16_t)f2bf(yr * tc + yi * ts); yrow[128 + nb * 32] = (bf16_t)f2bf(yi * tc - yr * ts); } }
    }
    __syncthreads();
}
__device__ const float C16T[16] = {1.f, 0.9238795325112867f, 0.7071067811865476f, 0.3826834323650898f, 0.f, -0.3826834323650898f, -0.7071067811865476f, -0.9238795325112867f,
                                   -1.f, -0.9238795325112867f, -0.7071067811865476f, -0.3826834323650898f, 0.f, 0.3826834323650898f, 0.7071067811865476f, 0.9238795325112867f};
__device__ __forceinline__ void fa_prompt(const Params& P) {
    const bf16_t* U = (const bf16_t*)(P.ws + WS_Q) + (size_t)3 * NTOK * 512; bf16_t* YP = (bf16_t*)(P.ws + WS_YP);
    const int NGT = gridDim.x * 512;
    for (int it = blockIdx.x * 512 + threadIdx.x; it < 16 * 128 * 256; it += NGT) {
        const int cp = it & 255, n2 = (it >> 8) & 127, b = it >> 15; float x0[16], x1[16];
#pragma unroll
        for (int n1 = 0; n1 < 16; ++n1) { const unsigned w = *(const unsigned*)(U + ((size_t)b * SEQ_P + 128 * n1 + n2) * 512 + 2 * cp); x0[n1] = __builtin_bit_cast(float, w << 16); x1[n1] = __builtin_bit_cast(float, w & 0xffff0000u); }
        const int col = 2 * cp, g = col >> 7, ch = col & 127;
#pragma unroll
        for (int k1 = 0; k1 < 16; ++k1) { float r0 = 0.f, i0 = 0.f, r1 = 0.f, i1 = 0.f;
#pragma unroll
            for (int n1 = 0; n1 < 16; ++n1) { const float c = C16T[(k1 * n1) & 15], s = C16T[((k1 * n1) + 12) & 15]; r0 += x0[n1] * c; i0 -= x0[n1] * s; r1 += x1[n1] * c; i1 -= x1[n1] * s; }
            const float fr = (float)(k1 * n2) * (1.0f / 2048.0f); const float sc = 0.022097086912079608f;
            const float tc = __builtin_amdgcn_cosf(fr) * sc, ts = __builtin_amdgcn_sinf(fr) * sc;
            bf16_t* yrow = YP + ((size_t)b * SEQ_P + (size_t)k1 * 128 + n2) * 1024 + g * 256 + ch;
            *(unsigned*)yrow = pk2(r0 * tc + i0 * ts, r1 * tc + i1 * ts); *(unsigned*)(yrow + 128) = pk2(i0 * tc - r0 * ts, i1 * tc - r1 * ts); }
    }
}
constexpr int XP = 528, FC_WG_OFF = 73728;
__device__ __forceinline__ void fc_stage_wg(const Params& P, unsigned char* lds, int g) {
    const bf16_t* W = (const bf16_t*)(P.ws + WS_WFD) + (size_t)(g * 128) * 1024 + g * 256;
#pragma unroll
    for (int i = 0; i < 8; ++i) { const int c = threadIdx.x + 512 * i, n = c >> 5, w = c & 31;
        *(u32x4*)(lds + FC_WG_OFF + n * XP + w * 16) = *(const u32x4*)(W + (size_t)n * 1024 + w * 8); }
}
__device__ __forceinline__ void fc_tile(const Params& P, unsigned char* lds, size_t tokb, int N1, int k1, int g) {
    const int tid = threadIdx.x, lane = tid & 63, wid = tid >> 6, r32 = lane & 31, hi = lane >> 5;
    const bf16_t* YP = (const bf16_t*)(P.ws + WS_YP);
#pragma unroll
    for (int i = 0; i < 8; ++i) { const int c = tid + 512 * i, n2 = c >> 5, w = c & 31;
        const u32x4 v = *(const u32x4*)(YP + (tokb + (size_t)k1 * 128 + n2) * 1024 + g * 256 + w * 8);
        *(u32x4*)(lds + n2 * FPB + w * 16) = v; }
    __syncthreads();
    const int wm = wid & 3, wn = wid >> 2;
    const bf16_t* Wc = (const bf16_t*)(P.ws + WS_DFT); const bf16_t* Ws = Wc + 16384; const bf16_t* Wn = Wc + 32768;
    const LAS unsigned char* lb = (const LAS unsigned char*)lds + (8 * hi + ((lane & 15) >> 2)) * FPB + (16 * ((lane >> 4) & 1) + 4 * (lane & 3)) * 2 + wn * 128;
    f32x16 ar[2] = {}, ai[2] = {};
#pragma unroll 4
    for (int kk = 0; kk < 8; ++kk) { const int ao = (wm * 32 + r32) * 128 + kk * 16 + 8 * hi;
        const bf16x8 fc = *(const bf16x8*)(Wc + ao), fs = *(const bf16x8*)(Ws + ao), fn = *(const bf16x8*)(Wn + ao);
#pragma unroll
        for (int nb = 0; nb < 2; ++nb) { const bf16x8 bre = fft_bfrag(lb + kk * 16 * FPB + nb * 64), bim = fft_bfrag(lb + kk * 16 * FPB + 256 + nb * 64);
            ar[nb] = __builtin_amdgcn_mfma_f32_32x32x16_bf16(fc, bre, ar[nb], 0, 0, 0); ar[nb] = __builtin_amdgcn_mfma_f32_32x32x16_bf16(fs, bim, ar[nb], 0, 0, 0);
            ai[nb] = __builtin_amdgcn_mfma_f32_32x32x16_bf16(fc, bim, ai[nb], 0, 0, 0); ai[nb] = __builtin_amdgcn_mfma_f32_32x32x16_bf16(fn, bre, ai[nb], 0, 0, 0); }
    }
    __syncthreads();
#pragma unroll
    for (int r = 0; r < 16; ++r) { const int k2 = wm * 32 + crow16(r, hi); bf16_t* xr = (bf16_t*)(lds + k2 * XP) + wn * 64 + r32;
#pragma unroll
        for (int nb = 0; nb < 2; ++nb) { xr[nb * 32] = (bf16_t)f2bf(ar[nb][r]); xr[128 + nb * 32] = (bf16_t)f2bf(ai[nb][r]); } }
    __syncthreads();
    const unsigned char* wgl = lds + FC_WG_OFF + (wn * 64 + r32) * XP + 16 * hi;
    const unsigned char* xa = lds + (wm * 32 + r32) * XP + 16 * hi;
    f32x16 oc[2] = {};
#pragma unroll 4
    for (int kk = 0; kk < 16; ++kk) { const bf16x8 af = *(const bf16x8*)(xa + kk * 32);
#pragma unroll
        for (int nb = 0; nb < 2; ++nb) { const bf16x8 bfr = *(const bf16x8*)(wgl + nb * 32 * XP + kk * 32);
            oc[nb] = __builtin_amdgcn_mfma_f32_32x32x16_bf16(af, bfr, oc[nb], 0, 0, 0); } }
    bf16_t* MX = (bf16_t*)(P.ws + WS_MIX);
#pragma unroll
    for (int r = 0; r < 16; ++r) { const int k2 = wm * 32 + crow16(r, hi);
        bf16_t* orow = MX + (tokb + (size_t)k1 + (size_t)N1 * k2) * 1024 + 512 + g * 128 + wn * 64 + r32;
#pragma unroll
        for (int nb = 0; nb < 2; ++nb) orow[nb * 32] = (bf16_t)f2bf(oc[nb][r]); }
    __syncthreads();
}

#define XB_TMO      128
#define XB_XCNT(j)  (256  + 64 * (j))
#define XB_XSUB(j)  (1280 + 64 * (j))
#define XB_XGEN(j)  (2304 + 64 * (j))
#define XB_TOP      3328
#define XB_TOPGEN   3392
#define XCD_BAR_WORDS 3456
#define XB_SPIN_CAP (1u << 18)

__device__ __forceinline__ unsigned xb_ld(unsigned* p)              { return __hip_atomic_load(p, __ATOMIC_RELAXED, __HIP_MEMORY_SCOPE_AGENT); }
__device__ __forceinline__ unsigned xb_add(unsigned* p, unsigned v) { return __hip_atomic_fetch_add(p, v, __ATOMIC_RELAXED, __HIP_MEMORY_SCOPE_AGENT); }
__device__ __forceinline__ unsigned xb_xcc_id() { return (unsigned)__builtin_amdgcn_s_getreg((3 << 11) | 20) & 0xFu; }
#define XB_SPIN(cond, bar) do { unsigned _sp = 0; while (cond) { __builtin_amdgcn_s_sleep(1); \
    if ((++_sp & 255u) == 0u) { if (xb_ld(&(bar)[XB_TMO])) break; if (_sp > XB_SPIN_CAP) { atomicAdd(&(bar)[XB_TMO], 1u); break; } } } } while (0)

struct XcdBarrier {
    unsigned* bar; unsigned x;
    volatile LAS unsigned* st;
};

__device__ __forceinline__ XcdBarrier xcd_barrier_post(unsigned* bar, volatile LAS unsigned* st) {
    XcdBarrier b; b.bar = bar; b.x = xb_xcc_id(); b.st = st;
    if (threadIdx.x == 0) (void)xb_add(&bar[XB_XCNT(b.x)], 1u);
    return b;
}
__device__ __forceinline__ void xcd_barrier_complete(unsigned* bar, unsigned x, unsigned& nloc, unsigned& nx) {
    const unsigned G = gridDim.x * gridDim.y * gridDim.z;
    unsigned sum, cnt, mine, sp = 0u;
    for (;;) {
        sum = 0u; cnt = 0u; mine = 0u;
#pragma unroll
        for (unsigned j = 0; j < 16; ++j) { const unsigned c = xb_ld(&bar[XB_XCNT(j)]); sum += c; cnt += (c > 0u) ? 1u : 0u; mine = (j == x) ? c : mine; }
        if (sum == G) break;
        __builtin_amdgcn_s_sleep(1);
        if ((++sp & 255u) == 0u) { if (xb_ld(&bar[XB_TMO])) break; if (sp > XB_SPIN_CAP) { atomicAdd(&bar[XB_TMO], 1u); break; } }
    }
    nloc = mine > 0u ? mine : 1u; nx = cnt > 0u ? cnt : 1u;
}

__device__ __forceinline__ void xcd_barrier(const XcdBarrier& b) {
    asm volatile("s_waitcnt vmcnt(0)" ::: "memory");
    __syncthreads();
    if (threadIdx.x == 0) {
        unsigned* bar = b.bar;
        __builtin_amdgcn_s_waitcnt(0);
        unsigned nloc = b.st[0], nx = b.st[1];
        if (nloc == 0u) { xcd_barrier_complete(bar, b.x, nloc, nx); b.st[0] = nloc; b.st[1] = nx; }
        const unsigned old = xb_add(&bar[XB_XSUB(b.x)], 1u);
        const unsigned gen = old / nloc;
        if (old + 1u == (gen + 1u) * nloc) {
            __builtin_amdgcn_fence(__ATOMIC_RELEASE, "agent");
            asm volatile("s_waitcnt vmcnt(0)" ::: "memory");
            const unsigned og = xb_add(&bar[XB_TOP], 1u);
            const unsigned tg = og / nx;
            if (og + 1u == (tg + 1u) * nx) xb_add(&bar[XB_TOPGEN], 1u);
            else XB_SPIN(xb_ld(&bar[XB_TOPGEN]) == tg, bar);
            __builtin_amdgcn_fence(__ATOMIC_ACQUIRE, "agent");
            xb_add(&bar[XB_XGEN(b.x)], 1u);
            asm volatile("s_waitcnt vmcnt(0)" ::: "memory");
        } else {
            XB_SPIN(xb_ld(&bar[XB_XGEN(b.x)]) == gen, bar);
            __builtin_amdgcn_fence(__ATOMIC_ACQUIRE, "agent");
            asm volatile("s_waitcnt vmcnt(0)" ::: "memory");
        }
    }
    __syncthreads();
}

__device__ __forceinline__ void grid_bar(unsigned* ctr, unsigned target) {
    asm volatile("s_waitcnt vmcnt(0) lgkmcnt(0)" ::: "memory");
    __syncthreads();
    if (threadIdx.x == 0) {
        __builtin_amdgcn_fence(__ATOMIC_RELEASE, "agent");
        asm volatile("s_waitcnt vmcnt(0)" ::: "memory");
        __hip_atomic_fetch_add(ctr, 1u, __ATOMIC_RELAXED, __HIP_MEMORY_SCOPE_AGENT);
        while (__hip_atomic_load(ctr, __ATOMIC_RELAXED, __HIP_MEMORY_SCOPE_AGENT) < target) __builtin_amdgcn_s_sleep(2);
        __builtin_amdgcn_fence(__ATOMIC_ACQUIRE, "agent");
        asm volatile("s_waitcnt vmcnt(0)" ::: "memory");
    }
    __syncthreads();
}

__global__ void __launch_bounds__(512, 2) fwd_megakernel(Params P) {
    extern __shared__ __attribute__((aligned(16))) unsigned char lds[];
    cg::grid_group grid = cg::this_grid();
    unsigned char* ws = P.ws; const int G = gridDim.x, bid = blockIdx.x;
    bf16_t* Qb = (bf16_t*)(ws + WS_Q); const size_t QS = (size_t)NTOK * 512;
    const float* mod = (const float*)(ws + WS_MOD);
    volatile LAS unsigned* xst = (volatile LAS unsigned*)((LAS unsigned char*)lds + (LDS_BYTES - 64));
    if (threadIdx.x < 2) xst[threadIdx.x] = 0u;
    __syncthreads();
    const XcdBarrier xbar = xcd_barrier_post((unsigned*)(ws + WS_BAR), xst);
#define GBAR() xcd_barrier(xbar)

    p0_prologue(P, lds);
    grid.sync();
    p1_lnmod(P);
    GBAR();
#ifndef NO_PH_P2
    { pg8::Gemm g{(const bf16_t*)(ws + WS_H1), (const bf16_t*)(ws + WS_WIN), NTOK, 2048, 1024}; pg8::StaticOrder S; S.init(NTOK, 2048, G, bid);
      pg8::EpiInProj E{Qb, (const float*)(ws + WS_ROPE)};
      pg8::gemm_phase<pg8::EpiInProj, pg8::StaticOrder, true, true>((LAS unsigned char*)lds, g, S, E); }
#endif
    GBAR();
#ifndef NO_PH_FA
    for (int t = bid; t < 512; t += G) fa_sample_tile(P, lds, t);
    fa_prompt(P);
#endif
    GBAR();
#ifndef NO_PH_FC
    { int g_staged = -1;
      for (int t = bid; t < 2048; t += G) {
        const int g = t & 3;
        if (g != g_staged) { __syncthreads(); fc_stage_wg(P, lds, g); g_staged = g; }
        if (t < 1024) { const int k1 = (t >> 2) & 127, b = t >> 9; fc_tile(P, lds, (size_t)TOKP + (size_t)b * SEQ_S, 128, k1, g); }
        else { const int t2 = t - 1024, k1 = (t2 >> 2) & 15, b = t2 >> 6; fc_tile(P, lds, (size_t)b * SEQ_P, 16, k1, g); }
      } }
#endif
    __syncthreads();
#ifndef NO_PH_ATT
    {
        float lam;
        { float s1 = 0.f, s2 = 0.f;
          for (int i = 0; i < 64; ++i) { s1 += P.in[I_LQ1][i] * P.in[I_LK1][i]; s2 += P.in[I_LQ2][i] * P.in[I_LK2][i]; }
          lam = expf(s1) - expf(s2) + LAMBDA_INIT; }
        for (int idx = bid; idx < 2048; idx += G) {
            int b, h, qb, seq; size_t tok0;
            if (idx < 1024) { const int bh = idx & 7; qb = idx >> 3; b = bh >> 2; h = bh & 3; seq = SEQ_S; tok0 = (size_t)TOKP + (size_t)b * SEQ_S; }
            else { const int i2 = idx - 1024, x = i2 & 7, y = i2 >> 3; qb = y & 15; const int bh = x + 8 * (y >> 4); b = bh >> 2; h = bh & 3; seq = SEQ_P; tok0 = (size_t)b * SEQ_P; }
            const bf16_t* Qp = Qb + (tok0 + (size_t)qb * 128) * 512 + h * 128; const bf16_t* Kp = Qb + QS + tok0 * 512 + h * 128; const bf16_t* Vp = Qb + 2 * QS + tok0 * 512 + h * 128;
            bf16_t* Op = (bf16_t*)(ws + WS_MIX) + (tok0 + (size_t)qb * 128) * 1024 + h * 128;
            if (!att::attn_unit<true>(Qp, Kp, Vp, Op, seq, (char*)lds, lam, P.in[I_SUBG]))
                (void)att::attn_unit<false>(Qp, Kp, Vp, Op, seq, (char*)lds, lam, P.in[I_SUBG]);
        }
    }
#endif
    GBAR();
#ifndef NO_PH_P4
    { pg8::Gemm g{(const bf16_t*)(ws + WS_MIX), (const bf16_t*)(ws + WS_WOUT), NTOK, 1024, 1024}; pg8::StaticOrder S; S.init(NTOK, 1024, G, bid);
      pg8::EpiResidBf E{P.in[I_XP], P.in[I_XS], (bf16_t*)(ws + WS_Y1), mod + 2048};
      pg8::gemm_phase<pg8::EpiResidBf, pg8::StaticOrder, true, true>((LAS unsigned char*)lds, g, S, E); }
#endif
    GBAR();
#ifndef NO_PH_P5
    p5_ln1(P);
#endif
    GBAR();
#ifndef NO_PH_P6
    { pg8::Gemm g{(const bf16_t*)(ws + WS_MIX), (const bf16_t*)(ws + WS_WGU), NTOK, 5632, 1024}; pg8::StaticOrder S; S.init(NTOK, 5632, G, bid);
      pg8::EpiGateUp E{(bf16_t*)(ws + WS_A)};
      pg8::gemm_phase<pg8::EpiGateUp, pg8::StaticOrder, true, true>((LAS unsigned char*)lds, g, S, E); }
#endif
    GBAR();
#ifndef NO_PH_P7
    { pg8::Gemm g{(const bf16_t*)(ws + WS_A), (const bf16_t*)(ws + WS_WDN), NTOK, 1024, 2816}; pg8::StaticOrder S; S.init(NTOK, 1024, G, bid);
      pg8::EpiResidLn E{(const bf16_t*)(ws + WS_Y1), (const float*)(ws + WS_STAT), P.in[I_LN1G], P.in[I_LN1B], (bf16_t*)(ws + WS_X), mod + 5120};
      pg8::gemm_phase<pg8::EpiResidLn, pg8::StaticOrder, true, true>((LAS unsigned char*)lds, g, S, E); }
#endif
    GBAR();
#ifndef NO_PH_P8
    p8_ln2(P);
#endif
}

extern "C" void kernel_launch(void* const* d_in, const int* in_sizes, int n_in, void* d_out, int out_size, void* d_ws, size_t ws_size, hipStream_t stream) {
    static int grid = 0;
    if (grid == 0) {
        if (n_in != 21 || out_size != NTOK * DM || ws_size < WS_END + 16384) { fprintf(stderr, "kernel_launch: unexpected shapes (n_in %d out %d ws %zu)\n", n_in, out_size, ws_size); grid = -1; return; }
        int dev = 0, cus = 0, per_cu = 0;
        (void)hipGetDevice(&dev); (void)hipDeviceGetAttribute(&cus, hipDeviceAttributeMultiprocessorCount, dev);
        if (hipFuncSetAttribute((const void*)fwd_megakernel, hipFuncAttributeMaxDynamicSharedMemorySize, LDS_BYTES) != hipSuccess) { fprintf(stderr, "kernel_launch: hipFuncSetAttribute failed\n"); grid = -1; return; }
        if (hipOccupancyMaxActiveBlocksPerMultiprocessor(&per_cu, (const void*)fwd_megakernel, 512, LDS_BYTES) != hipSuccess || per_cu < 1) { fprintf(stderr, "kernel_launch: occupancy query gave %d\n", per_cu); per_cu = 1; }
        (void)hipGetLastError();
        grid = cus * 1;
        if (grid <= 0) grid = 256;
    }
    if (grid < 0) return;
    Params p{};
    for (int i = 0; i < 21; ++i) p.in[i] = (const float*)d_in[i];
    p.out = (float*)d_out; p.ws = (unsigned char*)d_ws;
    for (int i = 0; i < 32; ++i) p.inv_freq[i] = (float)pow(10000.0, -(double)i / 32.0);
    (void)hipMemsetAsync((unsigned char*)d_ws + WS_BAR, 0, 16384, stream);
    void* args[] = {&p};
    hipError_t e = hipLaunchCooperativeKernel((const void*)fwd_megakernel, dim3(grid), dim3(512), args, LDS_BYTES, stream);
    if (e != hipSuccess) fprintf(stderr, "kernel_launch: cooperative launch failed: %s (grid %d)\n", hipGetErrorString(e), grid);
}
```
